# Optimizing an MI355X kernel written in HIP

```python
import jax, jax.numpy as jnp
from jax import lax
import numpy as np

D_MODEL = 2048
BATCH = 2
SEQ = 4096
DEPTH = 1

RWKV_HEAD_DIM = 64
RWKV_HEADS = (D_MODEL // 2) // RWKV_HEAD_DIM
RWKV_DIM = RWKV_HEADS * RWKV_HEAD_DIM
DECAY_LORA = 64
ICLR_LORA = 64
GATE_LORA = 160
ATTN_HEAD_DIM = 64
ATTN_Q_HEADS = (D_MODEL // 2) // ATTN_HEAD_DIM
ATTN_KV_HEADS = max(1, ATTN_Q_HEADS // 8)
ATTN_GROUP = ATTN_Q_HEADS // ATTN_KV_HEADS
WINDOW = 128
FFN_DIM = 4 * D_MODEL
NORM_EPS = 1e-6
RWKV_GN_EPS = 64e-5
N_BRANCHES = 2

RWKV_COLS = 3 * RWKV_DIM + DECAY_LORA + ICLR_LORA + GATE_LORA
ATTN_Q_COLS = ATTN_Q_HEADS * ATTN_HEAD_DIM
ATTN_KV_COLS = ATTN_KV_HEADS * ATTN_HEAD_DIM
ATTN_COLS = ATTN_Q_COLS + 2 * ATTN_KV_COLS
GATE_COLS = N_BRANCHES * D_MODEL
IN_COLS = RWKV_COLS + ATTN_COLS + GATE_COLS

kernel_name = "hybrid_rwkv7_swa_sink_alibi_block"


def rms_norm(x, gain):
    x32 = x.astype(jnp.float32)
    y = x32 * lax.rsqrt(jnp.mean(x32 * x32, axis=-1, keepdims=True) + NORM_EPS)
    return (y * gain.astype(jnp.float32)).astype(x.dtype)


def token_shift(p):
    return jnp.pad(p, ((0, 0), (1, 0), (0, 0)))[:, :-1]


def rwkv7_scan(r, decay, k, v, a, b):
    B, T, H, N = r.shape

    def step(S, inp):
        r_t, w_t, k_t, v_t, a_t, b_t = inp
        sa = jnp.einsum('bhij,bhj->bhi', S, a_t)
        S = S * w_t[:, :, None, :] + sa[..., None] * b_t[:, :, None, :] + v_t[..., None] * k_t[:, :, None, :]
        y = jnp.einsum('bhij,bhj->bhi', S, r_t)
        return S, y

    xs = tuple(jnp.moveaxis(t, 1, 0) for t in (r, decay, k, v, a, b))
    S0 = jnp.zeros((B, H, N, N), jnp.float32)
    _, y = lax.scan(step, S0, xs)
    return jnp.moveaxis(y, 0, 1)


def rwkv7_branch(p, mix, w0, w2, a0, a2, g2, k_k, k_a, r_k, ln_w, ln_b):
    B, T, _ = p.shape
    H, N, C = RWKV_HEADS, RWKV_HEAD_DIM, RWKV_DIM
    p = p + (token_shift(p) - p) * mix
    r = p[..., :C]
    k = p[..., C:2 * C]
    v = p[..., 2 * C:3 * C]
    o = 3 * C
    wd = p[..., o:o + DECAY_LORA]
    o += DECAY_LORA
    ad = p[..., o:o + ICLR_LORA]
    o += ICLR_LORA
    gd = p[..., o:o + GATE_LORA]

    w = -jax.nn.softplus(-(w0 + jnp.tanh(wd) @ w2)) - 0.5
    decay = jnp.exp(-jnp.exp(w.astype(jnp.float32)))
    a = jax.nn.sigmoid(a0 + ad @ a2)
    g = jax.nn.sigmoid(gd) @ g2

    hs = lambda t: t.reshape(B, T, H, N).astype(jnp.float32)
    kk = hs(k * k_k)
    kk = kk / jnp.maximum(jnp.sqrt(jnp.sum(kk * kk, axis=-1, keepdims=True)), 1e-12)
    k_mod = k * (1.0 + (a - 1.0) * k_a)
    r_h, k_h, v_h, a_h = hs(r), hs(k_mod), hs(v), hs(a)

    y = rwkv7_scan(r_h, hs(decay), k_h, v_h, -kk, kk * a_h)

    mu = jnp.mean(y, axis=-1, keepdims=True)
    var = jnp.mean(jnp.square(y - mu), axis=-1, keepdims=True)
    yn = ((y - mu) * lax.rsqrt(var + RWKV_GN_EPS)).reshape(B, T, C)
    yn = yn * ln_w.astype(jnp.float32) + ln_b.astype(jnp.float32)
    bonus = jnp.sum(r_h * k_h * r_k.astype(jnp.float32), axis=-1, keepdims=True) * v_h
    out = (yn + bonus.reshape(B, T, C)) * g.astype(jnp.float32)
    return out.astype(p.dtype)


def sliding_window_sink_attention(q, k, v, sinks):
    B, T = q.shape[:2]
    W, HKV, G, hd = WINDOW, ATTN_KV_HEADS, ATTN_GROUP, ATTN_HEAD_DIM
    nb = T // W
    qb = q.reshape(B, nb, W, HKV, G, hd)
    pad = ((0, 0), (W, 0), (0, 0), (0, 0))
    kp = jnp.pad(k, pad).reshape(B, nb + 1, W, HKV, hd)
    vp = jnp.pad(v, pad).reshape(B, nb + 1, W, HKV, hd)
    kw = jnp.concatenate([kp[:, :-1], kp[:, 1:]], axis=2)
    vw = jnp.concatenate([vp[:, :-1], vp[:, 1:]], axis=2)

    s = jnp.einsum('bnqhgd,bnkhd->bnhgqk', qb, kw).astype(jnp.float32) * (hd ** -0.5)
    qi = jnp.arange(W)[:, None]
    kj = jnp.arange(2 * W)[None, :]
    dist = qi + W - kj
    kpos = jnp.arange(nb)[:, None] * W - W + jnp.arange(2 * W)[None, :]
    valid = ((dist >= 0) & (dist < W))[None] & (kpos >= 0)[:, None, :]

    slopes = 2.0 ** (-8.0 * jnp.arange(1, ATTN_Q_HEADS + 1, dtype=jnp.float32) / ATTN_Q_HEADS)
    alibi = -slopes.reshape(HKV, G)[:, :, None, None] * dist.astype(jnp.float32)
    s = jnp.where(valid[None, :, None, None], s + alibi, -jnp.inf)
    sink = jnp.broadcast_to(sinks.astype(jnp.float32).reshape(HKV, G)[None, None, :, :, None, None],
                            s.shape[:-1] + (1,))
    prob = jax.nn.softmax(jnp.concatenate([s, sink], axis=-1), axis=-1)[..., :2 * W]
    o = jnp.einsum('bnhgqk,bnkhd->bnqhgd', prob.astype(v.dtype), vw)
    return o.reshape(B, T, ATTN_Q_HEADS * hd)


def setup_inputs(seed: int = 0) -> dict:
    key = jax.random.key(seed)
    ks = jax.random.split(key, 32)
    L, D = DEPTH, D_MODEL
    nrm = lambda k, shape, s: jax.random.normal(k, shape, jnp.float32) * s
    return {
        "x": nrm(ks[0], (BATCH, SEQ, D), 1.0),
        "c": nrm(ks[1], (BATCH, D), 1.0),
        "w_ada": nrm(ks[2], (L, D, 6 * D), 0.5 * D ** -0.5),
        "b_ada": nrm(ks[3], (L, 6 * D), 0.01),
        "norm1_gain": 1.0 + nrm(ks[4], (L, D), 0.02),
        "w_in": nrm(ks[5], (L, D, IN_COLS), D ** -0.5),
        "b_in": nrm(ks[6], (L, IN_COLS), 0.01),
        "rwkv_mix": jax.random.uniform(ks[7], (L, RWKV_COLS), jnp.float32, 0.0, 1.0),
        "rwkv_w0": jax.random.uniform(ks[8], (L, RWKV_DIM), jnp.float32, -6.0, -1.0),
        "rwkv_w2": nrm(ks[9], (L, DECAY_LORA, RWKV_DIM), 0.5 * DECAY_LORA ** -0.5),
        "rwkv_a0": nrm(ks[10], (L, RWKV_DIM), 0.1),
        "rwkv_a2": nrm(ks[11], (L, ICLR_LORA, RWKV_DIM), 0.5 * ICLR_LORA ** -0.5),
        "rwkv_g2": nrm(ks[12], (L, GATE_LORA, RWKV_DIM), GATE_LORA ** -0.5),
        "rwkv_k_k": 0.85 + nrm(ks[13], (L, RWKV_DIM), 0.05),
        "rwkv_k_a": 1.0 + nrm(ks[14], (L, RWKV_DIM), 0.05),
        "rwkv_r_k": -0.04 + nrm(ks[15], (L, RWKV_HEADS, RWKV_HEAD_DIM), 0.02),
        "rwkv_ln_w": 1.0 + nrm(ks[16], (L, RWKV_DIM), 0.02),
        "rwkv_ln_b": nrm(ks[17], (L, RWKV_DIM), 0.01),
        "attn_sinks": nrm(ks[18], (L, ATTN_Q_HEADS), 1.0),
        "w_branch_rwkv": nrm(ks[19], (L, RWKV_DIM, D), RWKV_DIM ** -0.5),
        "w_branch_attn": nrm(ks[20], (L, ATTN_Q_COLS, D), ATTN_Q_COLS ** -0.5),
        "w_out": nrm(ks[21], (L, D, D), D ** -0.5),
        "norm2_gain": 1.0 + nrm(ks[22], (L, D), 0.02),
        "w_up": nrm(ks[23], (L, D, FFN_DIM), D ** -0.5),
        "w_down": nrm(ks[24], (L, FFN_DIM, D), FFN_DIM ** -0.5),
        "final_gain": 1.0 + nrm(ks[25], (D,), 0.02),
    }


def reference(x, c, w_ada, b_ada, norm1_gain, w_in, b_in, rwkv_mix, rwkv_w0, rwkv_w2,
              rwkv_a0, rwkv_a2, rwkv_g2, rwkv_k_k, rwkv_k_a, rwkv_r_k, rwkv_ln_w, rwkv_ln_b,
              attn_sinks, w_branch_rwkv, w_branch_attn, w_out, norm2_gain, w_up, w_down,
              final_gain):
    B, T, D = x.shape
    c_act = jax.nn.silu(c)
    for l in range(DEPTH):
        mod = c_act @ w_ada[l] + b_ada[l]
        sh1, sc1, gt1, sh2, sc2, gt2 = [m[:, None, :] for m in jnp.split(mod, 6, axis=-1)]

        h = rms_norm(x, norm1_gain[l]) * (1.0 + sc1) + sh1
        p = h @ w_in[l] + b_in[l]
        p_rwkv = p[..., :RWKV_COLS]
        p_attn = p[..., RWKV_COLS:RWKV_COLS + ATTN_COLS]
        p_gate = p[..., RWKV_COLS + ATTN_COLS:]

        y_rwkv = rwkv7_branch(p_rwkv, rwkv_mix[l], rwkv_w0[l], rwkv_w2[l], rwkv_a0[l],
                              rwkv_a2[l], rwkv_g2[l], rwkv_k_k[l], rwkv_k_a[l], rwkv_r_k[l],
                              rwkv_ln_w[l], rwkv_ln_b[l])
        q = p_attn[..., :ATTN_Q_COLS].reshape(B, T, ATTN_Q_HEADS, ATTN_HEAD_DIM)
        k = p_attn[..., ATTN_Q_COLS:ATTN_Q_COLS + ATTN_KV_COLS].reshape(B, T, ATTN_KV_HEADS, ATTN_HEAD_DIM)
        v = p_attn[..., ATTN_Q_COLS + ATTN_KV_COLS:].reshape(B, T, ATTN_KV_HEADS, ATTN_HEAD_DIM)
        y_attn = sliding_window_sink_attention(q, k, v, attn_sinks[l])

        gates = jax.nn.sigmoid(p_gate)
        g_rwkv, g_attn = gates[..., :D], gates[..., D:]
        merged = g_rwkv * (y_rwkv @ w_branch_rwkv[l]) + g_attn * (y_attn @ w_branch_attn[l])
        x = x + gt1 * (merged @ w_out[l])

        h = rms_norm(x, norm2_gain[l]) * (1.0 + sc2) + sh2
        x = x + gt2 * (jnp.square(jax.nn.relu(h @ w_up[l])) @ w_down[l])
    return rms_norm(x, final_gain)
```

```cpp
#include <hip/hip_runtime.h>
#include <hip/hip_cooperative_groups.h>
#include <cstdio>
#include <cstdint>
namespace cg = cooperative_groups;
__device__ __forceinline__ int pg8_get_lane() { int l; asm volatile("v_mbcnt_lo_u32_b32 %0, -1, 0\n\tv_mbcnt_hi_u32_b32 %0, -1, %0" : "=v"(l)); return l; }
__device__ __forceinline__ int pg8_get_wave(__attribute__((address_space(3))) unsigned char* lds) { const unsigned hw = (unsigned)__builtin_amdgcn_s_getreg(0x2804) & 63u; const int w = ((volatile __attribute__((address_space(3))) int*)(lds + 131072 + 512))[hw]; return __builtin_amdgcn_readfirstlane(w); }
namespace pg8 {
#define PG8_LAS __attribute__((address_space(3)))
typedef unsigned short bf16_t;
typedef short bf16x8 __attribute__((ext_vector_type(8)));
typedef float f32x4 __attribute__((ext_vector_type(4)));
typedef unsigned u32x4 __attribute__((ext_vector_type(4)));
constexpr int BM = 256, BK = 64, HALF = 128, HTB = HALF * BK * 2  , STAGE_BYTES = 8 * HTB, NXCD = 8, WGM = 4;

__host__ __device__ __forceinline__ int lds_byte(int r, int c) { const int st = (r >> 4) * 2 + (c >> 5), rr = r & 15, cc = c & 31, ob = rr * 64 + cc * 2; return st * 1024 + (ob ^ (((ob >> 9) & 1) << 5)); }
__host__ __device__ __forceinline__ void stage_rc(int b, int& R, int& C) { const int st = b / 1024, sb = b % 1024, swz = sb ^ (((sb >> 9) & 1) << 5); R = (st >> 1) * 16 + swz / 64; C = (st & 1) * 32 + (swz % 64) / 2; }
__host__ __device__ __forceinline__ int perm32(int rho) { const int n = rho >> 4, i = rho & 15; return 8 * (i >> 2) + 4 * n + (i & 3); }

struct Unit { int pm, pn; };
struct Gemm { const bf16_t* A; const bf16_t* Bt; int M, N, K; };
struct StaticOrder {
    int nM, nN, nwg, G, c;
    __host__ __device__ void init(int M, int N, int G_, int c_) { nM = M / BM; nN = N / BM; nwg = nM * nN; G = G_; c = c_; }
    __host__ __device__ bool next(int i, Unit& u) const {
        const long L = (long)i * G + c; if (L >= nwg) return false;
        int wgid = (int)L; { const int q = nwg / NXCD, r = nwg % NXCD, xcd = wgid % NXCD, off = wgid / NXCD; wgid = (xcd < r ? xcd * (q + 1) : r * (q + 1) + (xcd - r) * q) + off; }
        const int nig = WGM * nN, gid = wgid / nig, fm = gid * WGM, gsz = (nM - fm) < WGM ? (nM - fm) : WGM;
        u.pm = fm + ((wgid % nig) % gsz); u.pn = (wgid % nig) / gsz; return true;
    }
    __device__ __forceinline__ void a_ready(const Unit&) const {}
    __device__ __forceinline__ void done(const Unit&) const {}
};

__device__ __forceinline__ unsigned cvt_pk_bf16(float lo, float hi) { unsigned r; asm volatile("v_cvt_pk_bf16_f32 %0, %1, %2" : "=v"(r) : "v"(lo), "v"(hi)); return r; }
typedef float f32x2 __attribute__((ext_vector_type(2)));
template <class Epi, class Sched, bool ALIGN_EPI = false, bool SP2 = false>
__device__ __forceinline__ void gemm_phase(PG8_LAS unsigned char* lds, const Gemm g, const Sched& S, const Epi& E) {
    const int lane = pg8_get_lane(), wid = pg8_get_wave(lds), tid = wid * 64 + lane;
    const int wr = wid >> 2, wc = wid & 3, fr = lane & 15, fq = lane >> 4;
    const int K = g.K, nt = K / BK;
    unsigned voffA[2], voffB[2];
#pragma unroll
    for (int i = 0; i < 2; ++i) { int R, C; stage_rc(tid * 16 + i * 8192, R, C); const int Rb = Epi::PERM ? ((R & ~31) + perm32(R & 31)) : R;
        voffA[i] = (unsigned)(R * K + C) * 2u; voffB[i] = (unsigned)(Rb * K + C) * 2u; }
    const size_t kstep = (size_t)(BK * 2);
    const size_t hstep = (size_t)HALF * K * 2;
    const size_t tstep = 2 * hstep;
    const unsigned ldsw = (unsigned)wid * 1024u;
    const int aoff = lds_byte(wr * 64 + fr, fq * 8), boff = lds_byte(wc * 32 + fr, fq * 8);
#define PG8_SA(b, h) (((b) * 2 + (h)) * HTB)
#define PG8_SB(b, h) ((4 + (b) * 2 + (h)) * HTB)
#define PG8_STAGE(bufoff, gbase, voff) do { _Pragma("unroll") for (int _i = 0; _i < 2; ++_i) \
        __builtin_amdgcn_global_load_lds((const unsigned*)((const char*)(gbase) + (voff)[_i]), (PG8_LAS unsigned*)(lds + (bufoff) + ldsw + _i * 8192), 16, 0, 0); } while (0)
#define PG8_LDA(dst, b, h) do { _Pragma("unroll") for (int m = 0; m < 4; ++m) _Pragma("unroll") for (int k = 0; k < 2; ++k) dst[m][k] = *(const PG8_LAS bf16x8*)(lds + PG8_SA(b, h) + aoff + m * 2048 + k * 1024); } while (0)
#define PG8_LDB(dst, b, h) do { _Pragma("unroll") for (int n = 0; n < 2; ++n) _Pragma("unroll") for (int k = 0; k < 2; ++k) dst[n][k] = *(const PG8_LAS bf16x8*)(lds + PG8_SB(b, h) + boff + n * 2048 + k * 1024); } while (0)
#define PG8_MMA(ai, bj, At, Bt) do { __builtin_amdgcn_s_setprio(1); _Pragma("unroll") for (int m = 0; m < 4; ++m) _Pragma("unroll") for (int n = 0; n < 2; ++n) _Pragma("unroll") for (int k = 0; k < 2; ++k) \
        acc[ai][bj][m][n] = __builtin_amdgcn_mfma_f32_16x16x32_bf16(Bt[n][k], At[m][k], acc[ai][bj][m][n], 0, 0, 0); __builtin_amdgcn_s_setprio(0); } while (0)
#define PG8_WAIT_V(n) asm volatile("s_waitcnt vmcnt(" #n ")" ::: "memory")
#define PG8_WAIT_L(n) asm volatile("s_waitcnt lgkmcnt(" #n ")" ::: "memory")
#define PG8_BAR __builtin_amdgcn_s_barrier()
#define PG8_SCHED __builtin_amdgcn_sched_barrier(0)
    Unit cur, nxt; int ui = 0;
    if (!S.next(0, cur)) return;
    f32x4 acc[2][2][4][2];
#pragma unroll
    for (int a = 0; a < 2; ++a)
#pragma unroll
        for (int b = 0; b < 2; ++b)
#pragma unroll
            for (int m = 0; m < 4; ++m)
#pragma unroll
                for (int n = 0; n < 2; ++n) acc[a][b][m][n] = (f32x4){0.f, 0.f, 0.f, 0.f};
    bf16x8 At[4][2], B0[2][2], B1[2][2];
    const char* cA = (const char*)g.A + (size_t)cur.pm * tstep; const char* cB = (const char*)g.Bt + (size_t)cur.pn * tstep;
    S.a_ready(cur);
    if constexpr (SP2) {
        PG8_STAGE(PG8_SB(0, 0), cB, voffB); PG8_STAGE(PG8_SB(0, 1), cB + hstep, voffB); PG8_STAGE(PG8_SA(0, 0), cA, voffA); PG8_STAGE(PG8_SA(0, 1), cA + hstep, voffA);
        if (wr == 1) PG8_BAR;
        PG8_WAIT_V(2); PG8_BAR;
        PG8_STAGE(PG8_SB(1, 0), cB + kstep, voffB); PG8_STAGE(PG8_SA(1, 0), cA + kstep, voffA); PG8_STAGE(PG8_SB(1, 1), cB + hstep + kstep, voffB);
        PG8_WAIT_V(6); PG8_BAR;
    } else {
        PG8_STAGE(PG8_SB(0, 0), cB, voffB); PG8_STAGE(PG8_SA(0, 0), cA, voffA); PG8_STAGE(PG8_SB(0, 1), cB + hstep, voffB); PG8_STAGE(PG8_SA(0, 1), cA + hstep, voffA);
        if (wr == 1) PG8_BAR;
        PG8_WAIT_V(4); PG8_BAR;
        PG8_STAGE(PG8_SB(1, 0), cB + kstep, voffB); PG8_STAGE(PG8_SA(1, 0), cA + kstep, voffA); PG8_STAGE(PG8_SB(1, 1), cB + hstep + kstep, voffB);
        PG8_WAIT_V(6); PG8_BAR;
    }
    for (;;) {
        const bool has_next = S.next(ui + 1, nxt);
        const char* nA = has_next ? (const char*)g.A + (size_t)nxt.pm * tstep : cA; const char* nB = has_next ? (const char*)g.Bt + (size_t)nxt.pn * tstep : cB;
        for (int t = 0; t < nt; t += 2) {
            const bool last = (t == nt - 2);
            const char* a1 = cA + (size_t)(t + 1) * kstep;
            const char* a2 = last ? nA : cA + (size_t)(t + 2) * kstep; const char* b2 = last ? nB : cB + (size_t)(t + 2) * kstep;
            const char* a3 = a2 + kstep; const char* b3 = b2 + kstep;
            if (last && has_next) S.a_ready(nxt);
            if constexpr (SP2) {
            PG8_LDB(B0, 0, 0); PG8_LDB(B1, 0, 1); PG8_SCHED; PG8_LDA(At, 0, 0); PG8_STAGE(PG8_SA(1, 1), a1 + hstep, voffA);
            PG8_WAIT_V(8); PG8_WAIT_L(0); PG8_BAR; PG8_MMA(0, 0, At, B0); PG8_MMA(0, 1, At, B1); PG8_BAR; PG8_SCHED;
            PG8_LDA(At, 0, 1); PG8_STAGE(PG8_SB(0, 0), b2, voffB); PG8_STAGE(PG8_SB(0, 1), b2 + hstep, voffB); PG8_STAGE(PG8_SA(0, 0), a2, voffA);
            PG8_WAIT_V(8); PG8_WAIT_L(0); PG8_BAR; PG8_MMA(1, 0, At, B0); PG8_MMA(1, 1, At, B1); PG8_BAR; PG8_SCHED;
            PG8_LDB(B0, 1, 0); PG8_LDB(B1, 1, 1); PG8_SCHED; PG8_LDA(At, 1, 0); PG8_STAGE(PG8_SA(0, 1), a2 + hstep, voffA);
            PG8_WAIT_V(8); PG8_WAIT_L(0); PG8_BAR; PG8_MMA(0, 0, At, B0); PG8_MMA(0, 1, At, B1); PG8_BAR; PG8_SCHED;
            PG8_LDA(At, 1, 1); PG8_STAGE(PG8_SB(1, 0), b3, voffB); PG8_STAGE(PG8_SB(1, 1), b3 + hstep, voffB); PG8_STAGE(PG8_SA(1, 0), a3, voffA);
            PG8_WAIT_V(8); PG8_WAIT_L(0); PG8_BAR; PG8_MMA(1, 0, At, B0); PG8_MMA(1, 1, At, B1); PG8_BAR; PG8_SCHED;
            } else {
            PG8_LDB(B0, 0, 0); PG8_SCHED; PG8_LDA(At, 0, 0); PG8_STAGE(PG8_SA(1, 1), a1 + hstep, voffA);
            PG8_WAIT_L(8); PG8_BAR; PG8_WAIT_L(0); PG8_MMA(0, 0, At, B0); PG8_BAR; PG8_SCHED;
            PG8_LDB(B1, 0, 1); PG8_STAGE(PG8_SB(0, 0), b2, voffB);
            PG8_BAR; PG8_WAIT_L(0); PG8_MMA(0, 1, At, B1); PG8_BAR;
            PG8_LDA(At, 0, 1); PG8_STAGE(PG8_SA(0, 0), a2, voffA);
            PG8_BAR; PG8_WAIT_L(0); PG8_MMA(1, 0, At, B0); PG8_BAR; PG8_SCHED;
            PG8_STAGE(PG8_SB(0, 1), b2 + hstep, voffB);
            PG8_WAIT_V(6); PG8_BAR; PG8_MMA(1, 1, At, B1); PG8_BAR;
            PG8_LDB(B0, 1, 0); PG8_SCHED; PG8_LDA(At, 1, 0); PG8_STAGE(PG8_SA(0, 1), a2 + hstep, voffA);
            PG8_WAIT_L(8); PG8_BAR; PG8_WAIT_L(0); PG8_MMA(0, 0, At, B0); PG8_BAR; PG8_SCHED;
            PG8_LDB(B1, 1, 1); PG8_STAGE(PG8_SB(1, 0), b3, voffB);
            PG8_BAR; PG8_WAIT_L(0); PG8_MMA(0, 1, At, B1); PG8_BAR;
            PG8_LDA(At, 1, 1); PG8_STAGE(PG8_SA(1, 0), a3, voffA);
            PG8_BAR; PG8_WAIT_L(0); PG8_MMA(1, 0, At, B0); PG8_BAR; PG8_SCHED;
            PG8_STAGE(PG8_SB(1, 1), b3 + hstep, voffB);
            PG8_WAIT_V(6); PG8_BAR; PG8_MMA(1, 1, At, B1); PG8_BAR;
            }
        }
        if constexpr (ALIGN_EPI) { if (wr == 0) PG8_BAR; }
        if constexpr (!Epi::AFTER_DRAIN) { E(acc, cur, wr, wc, fr, fq); S.done(cur); }
        if (!has_next) break;
#pragma unroll
        for (int a = 0; a < 2; ++a)
#pragma unroll
            for (int b = 0; b < 2; ++b)
#pragma unroll
                for (int m = 0; m < 4; ++m)
#pragma unroll
                    for (int n = 0; n < 2; ++n) acc[a][b][m][n] = (f32x4){0.f, 0.f, 0.f, 0.f};
        cur = nxt; cA = nA; cB = nB; ++ui;
        if constexpr (ALIGN_EPI) { if (wr == 1) PG8_BAR; }
    }
    PG8_WAIT_V(0);
    if constexpr (!ALIGN_EPI) { if (wr == 0) PG8_BAR; }
    PG8_BAR;
    if constexpr (Epi::AFTER_DRAIN) { E.fused(acc, cur, wr, wc, fr, fq, lds, wid, lane); S.done(cur); }
#undef PG8_SA
#undef PG8_SB
#undef PG8_STAGE
#undef PG8_LDA
#undef PG8_LDB
#undef PG8_MMA
#undef PG8_WAIT_V
#undef PG8_WAIT_L
#undef PG8_BAR
#undef PG8_SCHED
}
}

#ifndef N_LAUNCH_SPLIT
#define N_LAUNCH_SPLIT 0
#endif
#define LAS __attribute__((address_space(3)))
#define TID_TAB_OFF (131072 + 512)
__device__ __forceinline__ int get_lane() { int l; asm volatile("v_mbcnt_lo_u32_b32 %0, -1, 0\n\tv_mbcnt_hi_u32_b32 %0, -1, %0" : "=v"(l)); return l; }
__device__ __forceinline__ int get_wave(LAS unsigned char* lds) { const unsigned hw = (unsigned)__builtin_amdgcn_s_getreg(0x2804) & 63u; const int w = ((volatile LAS int*)(lds + TID_TAB_OFF))[hw]; return __builtin_amdgcn_readfirstlane(w); }
typedef unsigned short bf16;
typedef float f32x4 __attribute__((ext_vector_type(4)));
typedef short bf16x8 __attribute__((ext_vector_type(8)));
typedef unsigned u32x4 __attribute__((ext_vector_type(4)));
typedef unsigned u32x2 __attribute__((ext_vector_type(2)));
#define LDS_WAIT() asm volatile("s_waitcnt lgkmcnt(0)" ::: "memory")

constexpr int NB = 2, T = 4096, D = 2048, M = NB * T, C = 1024, FF = 8192;
constexpr int NIN = 8960;
constexpr int PC_R = 0, PC_K = 1024, PC_V = 2048, PC_LORA = 3072, PC_Q = 3584, PC_AK = 4608, PC_AV = 4736, PC_GR = 4864, PC_GA = 6912;
constexpr int KL = 384;
constexpr int MODW = 6 * D;

constexpr size_t MiB = 1u << 20;
constexpr size_t WS_MOD = 1 * MiB, WS_BIASP = 1 * MiB + 512 * 1024, WS_WLORA = 2 * MiB;
constexpr size_t WS_WIN = 8 * MiB, WS_WBR = 44 * MiB, WS_WBA = 48 * MiB, WS_WOUT = 52 * MiB, WS_WUP = 60 * MiB, WS_WDOWN = 92 * MiB;
constexpr size_t WS_YATT = 60 * MiB, WS_YR = 76 * MiB;
constexpr size_t WS_H = 124 * MiB;
constexpr size_t WS_P = 156 * MiB;
constexpr size_t WS_AL = 296 * MiB;
constexpr size_t WS_WL = 302 * MiB, WS_AS = 334 * MiB;
constexpr size_t WS_GG = 366 * MiB;
constexpr int LDS_BYTES = 131072 + 1024;

struct Args { const float* in[26]; float* out; unsigned char* ws; int ph_lo, ph_hi; };

__device__ __forceinline__ float bf2f(unsigned b) { return __uint_as_float(b << 16); }
__device__ __forceinline__ unsigned f2bf(float f) { unsigned u = __float_as_uint(f); return (u + 0x7fffu + ((u >> 16) & 1u)) >> 16; }
__device__ __forceinline__ unsigned pk2(float lo, float hi) { return f2bf(lo) | (f2bf(hi) << 16); }
__device__ __forceinline__ float sigm(float x) { return __builtin_amdgcn_rcpf(1.0f + __builtin_amdgcn_exp2f(-1.44269504f * x)); }
__device__ __forceinline__ float blo(unsigned w) { return __uint_as_float(w << 16); }
__device__ __forceinline__ float bhi(unsigned w) { return __uint_as_float(w & 0xffff0000u); }
__device__ __forceinline__ float wave_sum(float v) {
#pragma unroll
    for (int o = 1; o < 64; o <<= 1) v += __shfl_xor(v, o);
    return v;
}
#define DPP_ADD(v, ctrl) v += __builtin_bit_cast(float, __builtin_amdgcn_update_dpp(0, __builtin_bit_cast(int, v), ctrl, 0xF, 0xF, true))
__device__ __forceinline__ float rowsum16(float v) {
    DPP_ADD(v, 0xB1); DPP_ADD(v, 0x4E); DPP_ADD(v, 0x141); DPP_ADD(v, 0x140);
    return v;
}

struct EpiIn {
    static constexpr bool PERM = true, AFTER_DRAIN = false;
    bf16* P; const float* bias;
    __device__ __forceinline__ void operator()(const pg8::f32x4 (&acc)[2][2][4][2], const pg8::Unit& u, int wr, int wc, int fr, int fq) const {
        const bool gate = u.pn >= 19; const int row0 = u.pm * 256 + wr * 64 + fr;
#pragma unroll
        for (int bj = 0; bj < 2; ++bj) {
            const int col = u.pn * 256 + bj * 128 + wc * 32 + 8 * fq;
            const f32x4 b0 = *(const f32x4*)(bias + col), b1 = *(const f32x4*)(bias + col + 4);
#pragma unroll
            for (int ai = 0; ai < 2; ++ai)
#pragma unroll
                for (int m = 0; m < 4; ++m) {
                    f32x4 v0 = acc[ai][bj][m][0] + b0, v1 = acc[ai][bj][m][1] + b1;
                    if (gate) { v0 = (f32x4){sigm(v0[0]), sigm(v0[1]), sigm(v0[2]), sigm(v0[3])}; v1 = (f32x4){sigm(v1[0]), sigm(v1[1]), sigm(v1[2]), sigm(v1[3])}; }
                    u32x4 w; w.x = pg8::cvt_pk_bf16(v0[0], v0[1]); w.y = pg8::cvt_pk_bf16(v0[2], v0[3]); w.z = pg8::cvt_pk_bf16(v1[0], v1[1]); w.w = pg8::cvt_pk_bf16(v1[2], v1[3]);
                    *(u32x4*)(P + (size_t)(row0 + ai * 128 + m * 16) * NIN + col) = w;
                }
        }
    }
};
struct EpiLora {
    static constexpr bool PERM = false, AFTER_DRAIN = false;
    float* WLAS; bf16* GG; const float* lbias;
    __device__ __forceinline__ void operator()(const pg8::f32x4 (&acc)[2][2][4][2], const pg8::Unit& u, int wr, int wc, int fr, int fq) const {
        const int typ = u.pn >> 2, cb = (u.pn & 3) * 256 + wc * 32 + 4 * fq, row0 = u.pm * 256 + wr * 64 + fr;
        if (typ < 2) {
            float* dst = WLAS + (size_t)typ * ((size_t)M * C) + cb; const float* bias = lbias + typ * C + cb; const float scale = typ == 0 ? -0.60653066f : 1.0f;
#pragma unroll
            for (int ai = 0; ai < 2; ++ai)
#pragma unroll
                for (int m = 0; m < 4; ++m) { float* drow = dst + (size_t)(row0 + ai * 128 + m * 16) * C;
#pragma unroll
                    for (int bj = 0; bj < 2; ++bj)
#pragma unroll
                        for (int n = 0; n < 2; ++n) { const f32x4 b = *(const f32x4*)(bias + bj * 128 + 16 * n);
                            const f32x4 x = acc[ai][bj][m][n] + b; const f32x4 o = (f32x4){sigm(x[0]), sigm(x[1]), sigm(x[2]), sigm(x[3])} * scale;
                            *(f32x4*)(drow + bj * 128 + 16 * n) = o; }
                    asm volatile("" ::: "memory"); }
        } else {
            bf16* dst = GG + cb;
#pragma unroll
            for (int ai = 0; ai < 2; ++ai)
#pragma unroll
                for (int m = 0; m < 4; ++m) { bf16* drow = dst + (size_t)(row0 + ai * 128 + m * 16) * C;
#pragma unroll
                    for (int bj = 0; bj < 2; ++bj)
#pragma unroll
                        for (int n = 0; n < 2; ++n) { const f32x4 x = acc[ai][bj][m][n]; u32x2 w; w.x = pg8::cvt_pk_bf16(x[0], x[1]); w.y = pg8::cvt_pk_bf16(x[2], x[3]);
                            *(u32x2*)(drow + bj * 128 + 16 * n) = w; }
                    asm volatile("" ::: "memory"); }
        }
    }
};
template <int MODE> struct EpiBr {
    static constexpr bool PERM = true, AFTER_DRAIN = false;
    const bf16* P; bf16* TMP; bf16* MG;
    __device__ __forceinline__ void operator()(const pg8::f32x4 (&acc)[2][2][4][2], const pg8::Unit& u, int wr, int wc, int fr, int fq) const {
        const int row0 = u.pm * 256 + wr * 64 + fr;
#pragma unroll
        for (int ai = 0; ai < 2; ++ai)
#pragma unroll
            for (int m = 0; m < 4; ++m) { const size_t row = (size_t)(row0 + ai * 128 + m * 16);
#pragma unroll
                for (int bj = 0; bj < 2; ++bj) { const int cc = u.pn * 256 + bj * 128 + wc * 32 + 8 * fq;
                    const u32x4 gw = *(const u32x4*)(P + row * NIN + (MODE == 0 ? PC_GR : PC_GA) + cc);
                    const f32x4 g0 = (f32x4){blo(gw.x), bhi(gw.x), blo(gw.y), bhi(gw.y)}, g1 = (f32x4){blo(gw.z), bhi(gw.z), blo(gw.w), bhi(gw.w)};
                    f32x4 o0 = g0 * acc[ai][bj][m][0], o1 = g1 * acc[ai][bj][m][1];
                    if (MODE == 1) { const u32x4 tw = *(const u32x4*)(TMP + row * D + cc);
                        o0 += (f32x4){blo(tw.x), bhi(tw.x), blo(tw.y), bhi(tw.y)}; o1 += (f32x4){blo(tw.z), bhi(tw.z), blo(tw.w), bhi(tw.w)}; }
                    u32x4 w; w.x = pg8::cvt_pk_bf16(o0[0], o0[1]); w.y = pg8::cvt_pk_bf16(o0[2], o0[3]); w.z = pg8::cvt_pk_bf16(o1[0], o1[1]); w.w = pg8::cvt_pk_bf16(o1[2], o1[3]);
                    *(u32x4*)((MODE == 0 ? TMP : MG) + row * D + cc) = w; }
                asm volatile("" ::: "memory"); }
    }
};
struct EpiRes {
    static constexpr bool PERM = false, AFTER_DRAIN = false;
    const float* base; float* out; const float* gate;
    __device__ __forceinline__ void operator()(const pg8::f32x4 (&acc)[2][2][4][2], const pg8::Unit& u, int wr, int wc, int fr, int fq) const {
        const int row0 = u.pm * 256 + wr * 64 + fr; const float* gt = gate + (u.pm >> 4) * MODW;
#pragma unroll
        for (int bj = 0; bj < 2; ++bj)
#pragma unroll
            for (int n = 0; n < 2; ++n) { const int cc = u.pn * 256 + bj * 128 + wc * 32 + 16 * n + 4 * fq; const f32x4 g = *(const f32x4*)(gt + cc);
#pragma unroll
                for (int ai = 0; ai < 2; ++ai) {
#pragma unroll
                    for (int m = 0; m < 4; ++m) { const size_t off = (size_t)(row0 + ai * 128 + m * 16) * D + cc;
                        const f32x4 bs = *(const f32x4*)(base + off); *(f32x4*)(out + off) = bs + g * acc[ai][bj][m][n]; }
                    asm volatile("" ::: "memory"); } }
    }
};
struct EpiUp {
    static constexpr bool PERM = true, AFTER_DRAIN = false;
    bf16* U;
    __device__ __forceinline__ void operator()(const pg8::f32x4 (&acc)[2][2][4][2], const pg8::Unit& u, int wr, int wc, int fr, int fq) const {
        const int row0 = u.pm * 256 + wr * 64 + fr;
#pragma unroll
        for (int bj = 0; bj < 2; ++bj) { const int col = u.pn * 256 + bj * 128 + wc * 32 + 8 * fq;
#pragma unroll
            for (int ai = 0; ai < 2; ++ai)
#pragma unroll
                for (int m = 0; m < 4; ++m) { f32x4 v0 = acc[ai][bj][m][0], v1 = acc[ai][bj][m][1];
#pragma unroll
                    for (int j = 0; j < 4; ++j) { const float a0 = fmaxf(v0[j], 0.f), a1 = fmaxf(v1[j], 0.f); v0[j] = a0 * a0; v1[j] = a1 * a1; }
                    u32x4 w; w.x = pg8::cvt_pk_bf16(v0[0], v0[1]); w.y = pg8::cvt_pk_bf16(v0[2], v0[3]); w.z = pg8::cvt_pk_bf16(v1[0], v1[1]); w.w = pg8::cvt_pk_bf16(v1[2], v1[3]);
                    *(u32x4*)(U + (size_t)(row0 + ai * 128 + m * 16) * FF + col) = w; } }
    }
};

__device__ __forceinline__ void transpose_item(const float* W, int ldw, int nsrc0, bf16* WT, int K, int rowdst0, int kb, int nb, LAS float* scr, int lane) {
    const int k0 = 64 * kb, n0 = 32 * nb, r8 = lane >> 3, cq = lane & 7;
    f32x4 v[8];
#pragma unroll
    for (int i = 0; i < 8; ++i) v[i] = *(const f32x4*)(W + (size_t)(k0 + i * 8 + r8) * ldw + nsrc0 + n0 + cq * 4);
#pragma unroll
    for (int i = 0; i < 8; ++i) { LAS float* d = scr + (i * 8 + r8) * 33 + cq * 4; d[0] = v[i].x; d[1] = v[i].y; d[2] = v[i].z; d[3] = v[i].w; }
    LDS_WAIT();
    const int c = lane & 7;
#pragma unroll
    for (int j = 0; j < 4; ++j) { const int n = (lane >> 3) + 8 * j; const LAS float* s = scr + (8 * c) * 33 + n;
        u32x4 o; o.x = pk2(s[0 * 33], s[1 * 33]); o.y = pk2(s[2 * 33], s[3 * 33]); o.z = pk2(s[4 * 33], s[5 * 33]); o.w = pk2(s[6 * 33], s[7 * 33]);
        *(u32x4*)(WT + (size_t)(rowdst0 + n0 + n) * K + k0 + 8 * c) = o; }
    LDS_WAIT();
}

__device__ __forceinline__ void norm_rows_bf16(const float* X, const float* gain, const float* mod, int sc_off, int sh_off, bf16* H, int gw, int NGW, int lane) {
    for (int m = gw; m < M; m += NGW) {
        const f32x4* xr = (const f32x4*)(X + (size_t)m * D) + lane; f32x4 v[8]; float ss = 0.f;
#pragma unroll
        for (int j = 0; j < 8; ++j) { v[j] = xr[64 * j]; ss += (v[j].x * v[j].x + v[j].y * v[j].y) + (v[j].z * v[j].z + v[j].w * v[j].w); }
        const float rstd = rsqrtf(wave_sum(ss) * (1.f / D) + 1e-6f);
        const float* sc = mod + (m >> 12) * MODW + sc_off; const float* sh = mod + (m >> 12) * MODW + sh_off;
        u32x2* o8 = (u32x2*)(H + (size_t)m * D) + lane;
#pragma unroll
        for (int j = 0; j < 8; ++j) { const int c = j * 256 + lane * 4; const f32x4 g = *(const f32x4*)(gain + c), s = *(const f32x4*)(sc + c), h = *(const f32x4*)(sh + c);
            const f32x4 o = v[j] * rstd * g * (s + 1.f) + h; u32x2 w; w.x = pk2(o.x, o.y); w.y = pk2(o.z, o.w); o8[64 * j] = w; }
    }
}

__device__ __forceinline__ void attn_unit(const bf16* P, const float* sinks, bf16* YATT, int u, LAS unsigned char* lds, int tid) {
    const int wave = tid >> 6, lane = tid & 63, fr = lane & 15, fq = lane >> 4;
    const int b = u >> 7, kvh = (u >> 6) & 1, qb = u & 63, q0 = qb * 64, key0 = q0 - 128;
    LAS bf16* Ks = (LAS bf16*)lds;
    LAS bf16* Vt = (LAS bf16*)(lds + 192 * 144);
    for (int i = tid; i < 1536; i += 512) {
        const int row = i >> 3, c = i & 7, tk = key0 + row; u32x4 kv = (u32x4){0u, 0u, 0u, 0u}, vv = kv;
        if (tk >= 0) { const bf16* src = P + (size_t)(b * T + tk) * NIN; kv = *(const u32x4*)(src + PC_AK + kvh * 64 + c * 8); vv = *(const u32x4*)(src + PC_AV + kvh * 64 + c * 8); }
        *(LAS u32x4*)(Ks + row * 72 + c * 8) = kv;
        LAS bf16* vd = Vt + (c * 8) * 200 + row;
        vd[0 * 200] = (bf16)(vv.x & 0xffffu); vd[1 * 200] = (bf16)(vv.x >> 16); vd[2 * 200] = (bf16)(vv.y & 0xffffu); vd[3 * 200] = (bf16)(vv.y >> 16);
        vd[4 * 200] = (bf16)(vv.z & 0xffffu); vd[5 * 200] = (bf16)(vv.z >> 16); vd[6 * 200] = (bf16)(vv.w & 0xffffu); vd[7 * 200] = (bf16)(vv.w >> 16);
    }
    __syncthreads();
    const int hq = kvh * 8 + wave; const float slope = exp2f(-0.5f * (float)(hq + 1)), sink = sinks[hq];
    bf16x8 bqn[2];
#pragma unroll
    for (int ks = 0; ks < 2; ++ks) bqn[ks] = *(const bf16x8*)(P + (size_t)(b * T + q0 + fr) * NIN + PC_Q + hq * 64 + ks * 32 + fq * 8);
#pragma unroll 1
    for (int nq = 0; nq < 4; ++nq) {
        bf16x8 bq[2];
#pragma unroll
        for (int ks = 0; ks < 2; ++ks) { bq[ks] = bqn[ks]; bqn[ks] = *(const bf16x8*)(P + (size_t)(b * T + q0 + (nq < 3 ? nq + 1 : nq) * 16 + fr) * NIN + PC_Q + hq * 64 + ks * 32 + fq * 8); }
        f32x4 st[9];
#pragma unroll
        for (int i = 0; i < 9; ++i) { f32x4 acc = (f32x4){0.f, 0.f, 0.f, 0.f};
#pragma unroll
            for (int ks = 0; ks < 2; ++ks) { const bf16x8 ak = *(const LAS bf16x8*)(Ks + ((nq + i) * 16 + fr) * 72 + ks * 32 + fq * 8); acc = __builtin_amdgcn_mfma_f32_16x16x32_bf16(ak, bq[ks], acc, 0, 0, 0); }
            st[i] = acc; }
        float mx = sink;
#pragma unroll
        for (int i = 0; i < 9; ++i)
#pragma unroll
            for (int j = 0; j < 4; ++j) { const int kr = (nq + i) * 16 + fq * 4 + j; const int dist = nq * 16 + fr + 128 - kr; const bool valid = (dist >= 0) && (dist < 128) && (key0 + kr >= 0);
                const float s = valid ? (st[i][j] * 0.125f - slope * (float)dist) : -1e30f; st[i][j] = s; mx = fmaxf(mx, s); }
        mx = fmaxf(mx, __shfl_xor(mx, 16)); mx = fmaxf(mx, __shfl_xor(mx, 32));
        float sum = 0.f;
#pragma unroll
        for (int i = 0; i < 9; ++i)
#pragma unroll
            for (int j = 0; j < 4; ++j) { const float p = __expf(st[i][j] - mx); st[i][j] = p; sum += p; }
        sum += __shfl_xor(sum, 16); sum += __shfl_xor(sum, 32); sum += __expf(sink - mx);
        const float inv = 1.0f / sum;
        bf16x8 pb[5];
#pragma unroll
        for (int kk = 0; kk < 5; ++kk) { u32x4 w; w.x = pk2(st[2 * kk][0] * inv, st[2 * kk][1] * inv); w.y = pk2(st[2 * kk][2] * inv, st[2 * kk][3] * inv);
            if (kk < 4) { w.z = pk2(st[2 * kk + 1][0] * inv, st[2 * kk + 1][1] * inv); w.w = pk2(st[2 * kk + 1][2] * inv, st[2 * kk + 1][3] * inv); } else { w.z = 0u; w.w = 0u; }
            pb[kk] = __builtin_bit_cast(bf16x8, w); }
#pragma unroll
        for (int mh = 0; mh < 4; ++mh) { f32x4 o = (f32x4){0.f, 0.f, 0.f, 0.f};
#pragma unroll
            for (int kk = 0; kk < 5; ++kk) { const int tA = nq + 2 * kk, tB = (kk < 4) ? tA + 1 : tA;
                const u32x2 lo = *(const LAS u32x2*)(Vt + (mh * 16 + fr) * 200 + tA * 16 + fq * 4), hi = *(const LAS u32x2*)(Vt + (mh * 16 + fr) * 200 + tB * 16 + fq * 4);
                const u32x4 av = (u32x4){lo.x, lo.y, hi.x, hi.y};
                o = __builtin_amdgcn_mfma_f32_16x16x32_bf16(__builtin_bit_cast(bf16x8, av), pb[kk], o, 0, 0, 0); }
            u32x2 w; w.x = pk2(o[0], o[1]); w.y = pk2(o[2], o[3]);
            *(u32x2*)(YATT + (size_t)(b * T + q0 + nq * 16 + fr) * C + hq * 64 + mh * 16 + fq * 4) = w; }
    }
    __syncthreads();
}

typedef __bf16 bf16x2_t __attribute__((ext_vector_type(2)));
typedef float f32x2_t __attribute__((ext_vector_type(2)));
__device__ __forceinline__ unsigned cvtpk(float lo, float hi) { const f32x2_t v = {lo, hi}; const bf16x2_t b = __builtin_convertvector(v, bf16x2_t); return __builtin_bit_cast(unsigned, b); }
__device__ __forceinline__ int swz(int row, int col) { return row * 128 + ((((col >> 3) ^ (row >> 1)) & 7) << 4) + (col & 7) * 2; }
__device__ __forceinline__ void st_T(LAS unsigned char* dst, int x, int y0, f32x4 v) { u32x2 w; w.x = cvtpk(v[0], v[1]); w.y = cvtpk(v[2], v[3]); *(LAS u32x2*)(dst + swz(x, y0)) = w; }
__device__ __forceinline__ void st_N(LAS unsigned char* dst, int x, int y0, f32x4 v) {
#pragma unroll
    for (int r = 0; r < 4; ++r) *(LAS bf16*)(dst + swz(y0 + r, x)) = (bf16)f2bf(v[r]);
}
__device__ __forceinline__ f32x4 ld4(const LAS unsigned char* src, int x, int y0) { const u32x2 w = *(const LAS u32x2*)(src + swz(x, y0)); return (f32x4){blo(w.x), bhi(w.x), blo(w.y), bhi(w.y)}; }
template <class Epi> __device__ __forceinline__ void nt64(const LAS unsigned char* X, const LAS unsigned char* Y, int wave, int lane, Epi epi) {
    asm volatile("" : "+v"(wave), "+v"(lane));
    const int p = wave >> 1, q0 = (wave & 1) * 2, lr = lane & 15, kg = lane >> 4;
    bf16x8 ya[2], xb[2][2];
    const int yrow = p * 16 + lr;
#pragma unroll
    for (int ks = 0; ks < 2; ++ks) ya[ks] = *(const LAS bf16x8*)(Y + yrow * 128 + ((((ks * 4 + kg) ^ (yrow >> 1)) & 7) << 4));
#pragma unroll
    for (int qi = 0; qi < 2; ++qi) { const int xrow = (q0 + qi) * 16 + lr;
#pragma unroll
        for (int ks = 0; ks < 2; ++ks) xb[qi][ks] = *(const LAS bf16x8*)(X + xrow * 128 + ((((ks * 4 + kg) ^ (xrow >> 1)) & 7) << 4)); }
#pragma unroll
    for (int qi = 0; qi < 2; ++qi) { f32x4 acc = (f32x4){0.f, 0.f, 0.f, 0.f};
#pragma unroll
        for (int ks = 0; ks < 2; ++ks) acc = __builtin_amdgcn_mfma_f32_16x16x32_bf16(ya[ks], xb[qi][ks], acc, 0, 0, 0);
        epi((q0 + qi) * 16 + lr, p * 16 + kg * 4, acc); }
}
template <class E1, class E2> __device__ __forceinline__ void nt64_2(const LAS unsigned char* X1, const LAS unsigned char* Y1, E1 e1, const LAS unsigned char* X2, const LAS unsigned char* Y2, E2 e2, int wave, int lane) {
    asm volatile("" : "+v"(wave), "+v"(lane));
    const int p = wave >> 1, q0 = (wave & 1) * 2, lr = lane & 15, kg = lane >> 4;
    bf16x8 ya1[2], xb1[2][2], ya2[2], xb2[2][2];
    const int yrow = p * 16 + lr;
#pragma unroll
    for (int ks = 0; ks < 2; ++ks) { const int o = yrow * 128 + ((((ks * 4 + kg) ^ (yrow >> 1)) & 7) << 4); ya1[ks] = *(const LAS bf16x8*)(Y1 + o); ya2[ks] = *(const LAS bf16x8*)(Y2 + o); }
#pragma unroll
    for (int qi = 0; qi < 2; ++qi) { const int xrow = (q0 + qi) * 16 + lr;
#pragma unroll
        for (int ks = 0; ks < 2; ++ks) { const int o = xrow * 128 + ((((ks * 4 + kg) ^ (xrow >> 1)) & 7) << 4); xb1[qi][ks] = *(const LAS bf16x8*)(X1 + o); xb2[qi][ks] = *(const LAS bf16x8*)(X2 + o); } }
#pragma unroll
    for (int qi = 0; qi < 2; ++qi) { f32x4 acc = (f32x4){0.f, 0.f, 0.f, 0.f};
#pragma unroll
        for (int ks = 0; ks < 2; ++ks) acc = __builtin_amdgcn_mfma_f32_16x16x32_bf16(ya1[ks], xb1[qi][ks], acc, 0, 0, 0);
        e1((q0 + qi) * 16 + lr, p * 16 + kg * 4, acc); }
#pragma unroll
    for (int qi = 0; qi < 2; ++qi) { f32x4 acc = (f32x4){0.f, 0.f, 0.f, 0.f};
#pragma unroll
        for (int ks = 0; ks < 2; ++ks) acc = __builtin_amdgcn_mfma_f32_16x16x32_bf16(ya2[ks], xb2[qi][ks], acc, 0, 0, 0);
        e2((q0 + qi) * 16 + lr, p * 16 + kg * 4, acc); }
}
#define CB(i) (lds + (i) * 8192)
constexpr int CK_PLV = 15 * 8192, CK_SEG = 15 * 8192 + 256;

__device__ __forceinline__ u32x4 shfl_up8(u32x4 v) { u32x4 o; o.x = __shfl_up(v.x, 8); o.y = __shfl_up(v.y, 8); o.z = __shfl_up(v.z, 8); o.w = __shfl_up(v.w, 8); return o; }
struct ChunkRaw { u32x4 rc, kc, vc, rp, kp, vp; f32x4 wl0, wl1, as0, as1; };
__device__ __forceinline__ ChunkRaw chunk_load_raw(const bf16* P, const float* WL, const float* AS, int q, int tid) {
    const int hh = q >> 6, c = q & 63, bb = hh >> 4, h = hh & 15;
    const int t = tid >> 3, c0 = (tid & 7) * 8, tt = c * 64 + t, col = h * 64 + c0; const size_t row = (size_t)bb * T + tt;
    const bf16* pr = P + row * NIN; ChunkRaw R;
    R.rc = *(const u32x4*)(pr + PC_R + col); R.kc = *(const u32x4*)(pr + PC_K + col); R.vc = *(const u32x4*)(pr + PC_V + col);
    R.rp = (u32x4){0u, 0u, 0u, 0u}; R.kp = R.rp; R.vp = R.rp;
    if (tt > 0 && (tid & 56) == 0) { R.rp = *(const u32x4*)(pr - NIN + PC_R + col); R.kp = *(const u32x4*)(pr - NIN + PC_K + col); R.vp = *(const u32x4*)(pr - NIN + PC_V + col); }
    R.wl0 = *(const f32x4*)(WL + row * C + col); R.wl1 = *(const f32x4*)(WL + row * C + col + 4);
    R.as0 = *(const f32x4*)(AS + row * C + col); R.as1 = *(const f32x4*)(AS + row * C + col + 4);
    return R;
}
__device__ __forceinline__ void chunk_pass_a_prep(const ChunkRaw RW, const float* mix, const float* k_k, const float* k_a, const float* r_k, float* BON, int q, LAS unsigned char* lds, int tid) {
    const int hh = q >> 6, h = hh & 15;
    {
        const int t = tid >> 3, c0 = (tid & 7) * 8, col = h * 64 + c0;
        const u32x4 rc = RW.rc, kc = RW.kc, vc = RW.vc; const bool first = (tid & 56) == 0;
        const u32x4 rs = shfl_up8(rc), ks_ = shfl_up8(kc), vs = shfl_up8(vc); const u32x4 rp = first ? RW.rp : rs, kp = first ? RW.kp : ks_, vp = first ? RW.vp : vs; const f32x4 wl0 = RW.wl0, wl1 = RW.wl1, as0 = RW.as0, as1 = RW.as1;
        float r[8], k[8], v[8], rq[8], kq[8], vq[8], kk[8], wl[8], as[8];
        r[0] = blo(rc.x); r[1] = bhi(rc.x); r[2] = blo(rc.y); r[3] = bhi(rc.y); r[4] = blo(rc.z); r[5] = bhi(rc.z); r[6] = blo(rc.w); r[7] = bhi(rc.w);
        k[0] = blo(kc.x); k[1] = bhi(kc.x); k[2] = blo(kc.y); k[3] = bhi(kc.y); k[4] = blo(kc.z); k[5] = bhi(kc.z); k[6] = blo(kc.w); k[7] = bhi(kc.w);
        v[0] = blo(vc.x); v[1] = bhi(vc.x); v[2] = blo(vc.y); v[3] = bhi(vc.y); v[4] = blo(vc.z); v[5] = bhi(vc.z); v[6] = blo(vc.w); v[7] = bhi(vc.w);
        rq[0] = blo(rp.x); rq[1] = bhi(rp.x); rq[2] = blo(rp.y); rq[3] = bhi(rp.y); rq[4] = blo(rp.z); rq[5] = bhi(rp.z); rq[6] = blo(rp.w); rq[7] = bhi(rp.w);
        kq[0] = blo(kp.x); kq[1] = bhi(kp.x); kq[2] = blo(kp.y); kq[3] = bhi(kp.y); kq[4] = blo(kp.z); kq[5] = bhi(kp.z); kq[6] = blo(kp.w); kq[7] = bhi(kp.w);
        vq[0] = blo(vp.x); vq[1] = bhi(vp.x); vq[2] = blo(vp.y); vq[3] = bhi(vp.y); vq[4] = blo(vp.z); vq[5] = bhi(vp.z); vq[6] = blo(vp.w); vq[7] = bhi(vp.w);
#pragma unroll
        for (int e = 0; e < 4; ++e) { wl[e] = wl0[e]; wl[4 + e] = wl1[e]; as[e] = as0[e]; as[4 + e] = as1[e]; }
        float ss = 0.f;
#pragma unroll
        for (int e = 0; e < 8; ++e) { r[e] = r[e] + (rq[e] - r[e]) * mix[PC_R + col + e]; k[e] = k[e] + (kq[e] - k[e]) * mix[PC_K + col + e]; v[e] = v[e] + (vq[e] - v[e]) * mix[PC_V + col + e];
            kk[e] = k[e] * k_k[col + e]; ss += kk[e] * kk[e]; }
        ss += __shfl_xor(ss, 1); ss += __shfl_xor(ss, 2); ss += __shfl_xor(ss, 4);
        const float inv = 1.0f / fmaxf(sqrtf(ss), 1e-12f);
        LAS float* clb = (LAS float*)CB(13); LAS float* seg = (LAS float*)(lds + CK_SEG);
        *(LAS f32x4*)(clb + t * 64 + c0) = wl0; *(LAS f32x4*)(clb + t * 64 + c0 + 4) = wl1;
        __syncthreads();
        { const int j = tid & 63, sg = tid >> 6; float run = 0.f;
#pragma unroll
          for (int e = 0; e < 8; ++e) { run += clb[(sg * 8 + e) * 64 + j]; clb[(sg * 8 + e) * 64 + j] = run; }
          seg[sg * 64 + j] = run; }
        __syncthreads();
        float off[8], tot[8];
#pragma unroll
        for (int e = 0; e < 8; ++e) { off[e] = 0.f; tot[e] = 0.f; }
#pragma unroll
        for (int s = 0; s < 8; ++s) { const f32x4 s0 = *(const LAS f32x4*)(seg + s * 64 + c0), s1 = *(const LAS f32x4*)(seg + s * 64 + c0 + 4); const float m = (s < (t >> 3)) ? 1.f : 0.f;
#pragma unroll
            for (int e = 0; e < 4; ++e) { tot[e] += s0[e]; tot[4 + e] += s1[e]; off[e] += m * s0[e]; off[4 + e] += m * s1[e]; } }
        const f32x4 ci0 = *(const LAS f32x4*)(clb + t * 64 + c0), ci1 = *(const LAS f32x4*)(clb + t * 64 + c0 + 4);
        float oA[8], oB[8], oK[8], oR[8], oBh[8], oKh[8]; float sbon = 0.f;
#pragma unroll
        for (int e = 0; e < 8; ++e) { const float ci = (e < 4 ? ci0[e & 3] : ci1[e & 3]) + off[e]; const float er = __expf(ci), ea = __expf(ci - wl[e]), pt = __expf(tot[e]), eb = __builtin_amdgcn_rcpf(er), eh = pt * eb;
            const float kn = kk[e] * inv, bv = kn * as[e], km = k[e] * (1.f + (as[e] - 1.f) * k_a[col + e]);
            oA[e] = -kn * ea; oB[e] = bv * eb; oK[e] = km * eb; oR[e] = r[e] * er; oBh[e] = bv * eh; oKh[e] = km * eh; sbon += r[e] * km * r_k[col + e];
            if (t == 0) ((LAS float*)(lds + CK_PLV))[c0 + e] = pt; }
        sbon += __shfl_xor(sbon, 1); sbon += __shfl_xor(sbon, 2); sbon += __shfl_xor(sbon, 4);
        if ((tid & 7) == 0) { const int c_ = q & 63, bb_ = hh >> 4; BON[((size_t)bb_ * T + c_ * 64 + t) * 16 + h] = sbon; }
        u32x4 w;
        w.x = pk2(oA[0], oA[1]); w.y = pk2(oA[2], oA[3]); w.z = pk2(oA[4], oA[5]); w.w = pk2(oA[6], oA[7]); *(LAS u32x4*)(CB(0) + swz(t, c0)) = w;
        w.x = pk2(oB[0], oB[1]); w.y = pk2(oB[2], oB[3]); w.z = pk2(oB[4], oB[5]); w.w = pk2(oB[6], oB[7]); *(LAS u32x4*)(CB(2) + swz(t, c0)) = w;
        w.x = pk2(oK[0], oK[1]); w.y = pk2(oK[2], oK[3]); w.z = pk2(oK[4], oK[5]); w.w = pk2(oK[6], oK[7]); *(LAS u32x4*)(CB(3) + swz(t, c0)) = w;
        w.x = pk2(oR[0], oR[1]); w.y = pk2(oR[2], oR[3]); w.z = pk2(oR[4], oR[5]); w.w = pk2(oR[6], oR[7]); *(LAS u32x4*)(CB(4) + swz(t, c0)) = w;
#pragma unroll
        for (int e = 0; e < 8; ++e) { *(LAS bf16*)(CB(1) + swz(c0 + e, t)) = (bf16)f2bf(oA[e]); *(LAS bf16*)(CB(5) + swz(c0 + e, t)) = (bf16)f2bf(oBh[e]);
            *(LAS bf16*)(CB(6) + swz(c0 + e, t)) = (bf16)f2bf(oKh[e]); *(LAS bf16*)(CB(7) + swz(c0 + e, t)) = (bf16)f2bf(v[e]); }
    }
}
__device__ __forceinline__ void chunk_pass_a_mm(bf16* MC, bf16* QC, float* NC, float* YI, int q, LAS unsigned char* lds, int tid) {
    const int wave = tid >> 6, lane = tid & 63;
    __syncthreads();
    nt64_2(CB(2), CB(0), [=](int x, int y0, f32x4 v) {
#pragma unroll
        for (int r = 0; r < 4; ++r) v[r] = (x < y0 + r) ? v[r] : 0.f;
        st_T(CB(8), x, y0, v); st_N(CB(9), x, y0, v);
#pragma unroll
        for (int r = 0; r < 4; ++r) v[r] += (x == y0 + r) ? 1.f : 0.f;
        st_T(CB(13), x, y0, v); },
           CB(3), CB(0), [=](int x, int y0, f32x4 v) {
#pragma unroll
        for (int r = 0; r < 4; ++r) v[r] = (x < y0 + r) ? v[r] : 0.f;
        st_T(CB(10), x, y0, v); }, wave, lane);
    nt64_2(CB(4), CB(2), [=](int x, int y0, f32x4 v) {
#pragma unroll
        for (int r = 0; r < 4; ++r) v[r] = (y0 + r <= x) ? v[r] : 0.f;
        st_T(CB(11), x, y0, v); },
           CB(4), CB(3), [=](int x, int y0, f32x4 v) {
#pragma unroll
        for (int r = 0; r < 4; ++r) v[r] = (y0 + r <= x) ? v[r] : 0.f;
        st_T(CB(12), x, y0, v); }, wave, lane);
    __syncthreads();
    nt64(CB(8), CB(9), wave, lane, [=](int x, int y0, f32x4 v) { st_T(CB(2), x, y0, v); st_N(CB(3), x, y0, v); });
    __syncthreads();
    nt64_2(CB(13), CB(3), [=](int x, int y0, f32x4 v) { v += ld4(CB(13), x, y0); st_T(CB(14), x, y0, v); },
           CB(2), CB(3), [=](int x, int y0, f32x4 v) { st_T(CB(8), x, y0, v); st_N(CB(9), x, y0, v); }, wave, lane);
    __syncthreads();
    nt64_2(CB(14), CB(9), [=](int x, int y0, f32x4 v) { v += ld4(CB(14), x, y0); st_T(CB(13), x, y0, v); },
           CB(8), CB(9), [=](int x, int y0, f32x4 v) { st_T(CB(2), x, y0, v); st_N(CB(3), x, y0, v); }, wave, lane);
    __syncthreads();
    nt64_2(CB(13), CB(3), [=](int x, int y0, f32x4 v) { v += ld4(CB(13), x, y0); st_T(CB(14), x, y0, v); },
           CB(2), CB(3), [=](int x, int y0, f32x4 v) { st_T(CB(8), x, y0, v); st_N(CB(9), x, y0, v); }, wave, lane);
    __syncthreads();
    nt64_2(CB(14), CB(9), [=](int x, int y0, f32x4 v) { v += ld4(CB(14), x, y0); st_T(CB(13), x, y0, v); },
           CB(9), CB(8), [=](int x, int y0, f32x4 v) { st_T(CB(3), x, y0, v); }, wave, lane);
    __syncthreads();
    nt64(CB(13), CB(3), wave, lane, [=](int x, int y0, f32x4 v) { v += ld4(CB(13), x, y0); st_T(CB(14), x, y0, v); });
    __syncthreads();
    nt64_2(CB(5), CB(14), [=](int x, int y0, f32x4 v) { st_T(CB(2), x, y0, v); },
           CB(11), CB(14), [=](int x, int y0, f32x4 v) { st_T(CB(8), x, y0, v); }, wave, lane);
    __syncthreads();
    { bf16* mc = MC + (size_t)q * 4096; bf16* qc = QC + (size_t)q * 4096; const LAS float* plv = (const LAS float*)(lds + CK_PLV);
      nt64_2(CB(2), CB(1), [=](int x, int y0, f32x4 v) {
#pragma unroll
          for (int r = 0; r < 4; ++r) v[r] += (x == y0 + r) ? plv[x] : 0.f;
          u32x2 w; w.x = cvtpk(v[0], v[1]); w.y = cvtpk(v[2], v[3]); *(u32x2*)(mc + x * 64 + y0) = w; },
             CB(2), CB(10), [=](int x, int y0, f32x4 v) { v += ld4(CB(6), x, y0); st_T(CB(9), x, y0, v); }, wave, lane);
      nt64_2(CB(8), CB(1), [=](int x, int y0, f32x4 v) { v += ld4(CB(4), x, y0);
          u32x2 w; w.x = cvtpk(v[0], v[1]); w.y = cvtpk(v[2], v[3]); *(u32x2*)(qc + x * 64 + y0) = w; },
             CB(8), CB(10), [=](int x, int y0, f32x4 v) { v += ld4(CB(12), x, y0); st_T(CB(3), x, y0, v); }, wave, lane); }
    __syncthreads();
    { float* nc = NC + (size_t)q * 4096; bf16* yi = (bf16*)YI + (size_t)q * 4096;
      nt64_2(CB(7), CB(9), [=](int x, int y0, f32x4 v) { *(f32x4*)(nc + x * 64 + y0) = v; },
             CB(3), CB(7), [=](int x, int y0, f32x4 v) { u32x2 w; w.x = cvtpk(v[0], v[1]); w.y = cvtpk(v[2], v[3]); *(u32x2*)(yi + x * 64 + y0) = w; }, wave, lane); }
    __syncthreads();
}

__device__ __forceinline__ void chunk_pass_b(const bf16* MC, const float* NC, bf16* SC, int hh, int wave, int lane, volatile LAS int* prog) {
    const int i0 = wave * 16, lr = lane & 15, kg = lane >> 4;
    f32x4 st[4];
#pragma unroll
    for (int jt = 0; jt < 4; ++jt) st[jt] = (f32x4){0.f, 0.f, 0.f, 0.f};
    u32x2 mlo[3][4][2], mhi[3][4][2]; f32x4 nc[3][4];
#define PB_LOAD(S, CH) do { const int ch_ = (CH) < 64 ? (CH) : 63; const bf16* mc_ = MC + ((size_t)hh * 64 + ch_) * 4096; const float* nn_ = NC + ((size_t)hh * 64 + ch_) * 4096; \
        _Pragma("unroll") for (int jt = 0; jt < 4; ++jt) { nc[S][jt] = *(const f32x4*)(nn_ + (i0 + lr) * 64 + jt * 16 + kg * 4); \
            _Pragma("unroll") for (int ks = 0; ks < 2; ++ks) { mlo[S][jt][ks] = *(const u32x2*)(mc_ + (jt * 16 + lr) * 64 + (2 * ks) * 16 + kg * 4); mhi[S][jt][ks] = *(const u32x2*)(mc_ + (jt * 16 + lr) * 64 + (2 * ks + 1) * 16 + kg * 4); } } } while (0)
    PB_LOAD(0, 0); PB_LOAD(1, 1); PB_LOAD(2, 2);
    for (int c3 = 0; c3 < 66; c3 += 3) {
#pragma unroll
        for (int S = 0; S < 3; ++S) { const int c = c3 + S;
            u32x2 sp[4];
#pragma unroll
            for (int jt = 0; jt < 4; ++jt) { sp[jt].x = cvtpk(st[jt][0], st[jt][1]); sp[jt].y = cvtpk(st[jt][2], st[jt][3]); }
            if (c < 64) {
#pragma unroll
                for (int jt = 0; jt < 4; ++jt) *(u32x2*)(SC + ((size_t)hh * 64 + c) * 4096 + (i0 + lr) * 64 + jt * 16 + kg * 4) = sp[jt];
            }
            bf16x8 bfr[2];
#pragma unroll
            for (int ks = 0; ks < 2; ++ks) { const u32x4 w = (u32x4){sp[2 * ks].x, sp[2 * ks].y, sp[2 * ks + 1].x, sp[2 * ks + 1].y}; bfr[ks] = __builtin_bit_cast(bf16x8, w); }
#pragma unroll
            for (int jt = 0; jt < 4; ++jt) { f32x4 acc = nc[S][jt];
#pragma unroll
                for (int ks = 0; ks < 2; ++ks) { const u32x4 aw = (u32x4){mlo[S][jt][ks].x, mlo[S][jt][ks].y, mhi[S][jt][ks].x, mhi[S][jt][ks].y};
                    acc = __builtin_amdgcn_mfma_f32_16x16x32_bf16(__builtin_bit_cast(bf16x8, aw), bfr[ks], acc, 0, 0, 0); }
                st[jt] = acc; }
            PB_LOAD(S, c + 3);
        }
    }
#undef PB_LOAD
}
__device__ __forceinline__ void chunk_pass_b_touch(const bf16* MC, const float* NC, int hh, int slice, int hw, int lane, volatile LAS int* prog) {
    for (int c = 1 + hw; c < 64; c += 7) {
        while (*prog + 12 < c) __builtin_amdgcn_s_sleep(4);
        const u32x4* m = (const u32x4*)(MC + ((size_t)hh * 64 + c) * 4096) + lane; const u32x4* n = (const u32x4*)(NC + ((size_t)hh * 64 + c) * 4096 + slice * 16 * 64) + lane;
#pragma unroll
        for (int k = 0; k < 8; ++k) { const u32x4 v = m[64 * k]; asm volatile("" :: "v"(v)); }
#pragma unroll
        for (int k = 0; k < 4; ++k) { const u32x4 v = n[64 * k]; asm volatile("" :: "v"(v)); }
    }
}
__device__ __forceinline__ void chunk_pass_c(const bf16* QC, const bf16* SC, const float* YI, float* YRAW, int q, int wave, int lane) {
    const int hh = q >> 6, c = q & 63, bb = hh >> 4, h = hh & 15;
    const int p = wave >> 1, q0 = (wave & 1) * 2, lr = lane & 15, kg = lane >> 4;
    const bf16* qc = QC + (size_t)q * 4096; const bf16* sc = SC + (size_t)q * 4096; const float* yi = YI + (size_t)q * 4096;
    bf16x8 ya[2], xb[2][2];
#pragma unroll
    for (int ks = 0; ks < 2; ++ks) ya[ks] = *(const bf16x8*)(sc + (p * 16 + lr) * 64 + ks * 32 + kg * 8);
#pragma unroll
    for (int qi = 0; qi < 2; ++qi)
#pragma unroll
        for (int ks = 0; ks < 2; ++ks) xb[qi][ks] = *(const bf16x8*)(qc + ((q0 + qi) * 16 + lr) * 64 + ks * 32 + kg * 8);
#pragma unroll
    for (int qi = 0; qi < 2; ++qi) { const int t = (q0 + qi) * 16 + lr, i = p * 16 + kg * 4;
        f32x4 acc = *(const f32x4*)(yi + t * 64 + i);
#pragma unroll
        for (int ks = 0; ks < 2; ++ks) acc = __builtin_amdgcn_mfma_f32_16x16x32_bf16(ya[ks], xb[qi][ks], acc, 0, 0, 0);
        *(f32x4*)(YRAW + ((size_t)bb * T + c * 64 + t) * C + h * 64 + i) = acc; }
}

__device__ __forceinline__ void chunk_pass_c_fin(const bf16* QC, const bf16* SC, const float* YI, const bf16* P, const float* BON, const bf16* GG,
                                                 const float* mix, const float* ln_w, const float* ln_b, bf16* YR,
                                                 int q, int it, LAS unsigned char* lds, int tid, int wave, int lane) {
    const int hh = q >> 6, c = q & 63, bb = hh >> 4, h = hh & 15;
    const int t = tid >> 3, c0 = (tid & 7) * 8, tt = c * 64 + t, col = h * 64 + c0; const size_t row = (size_t)bb * T + tt;
    const bf16* pr = P + row * NIN;
    const u32x4 vc = *(const u32x4*)(pr + PC_V + col);
    u32x4 vp = (u32x4){0u, 0u, 0u, 0u};
    const bool first = (tid & 56) == 0;
    if (tt > 0 && first) vp = *(const u32x4*)(pr - NIN + PC_V + col);
    const float sb = BON[row * 16 + h];
    const u32x4 gw4 = *(const u32x4*)(GG + row * C + col);
    LAS float* yb = (LAS float*)lds + (it & 1) * (64 * 68);
    {
        const int p = wave >> 1, q0 = (wave & 1) * 2, lr = lane & 15, kg = lane >> 4;
        const bf16* qc = QC + (size_t)q * 4096; const bf16* sc = SC + (size_t)q * 4096; const bf16* yi = (const bf16*)YI + (size_t)q * 4096;
        bf16x8 ya[2], xb[2][2];
#pragma unroll
        for (int ks = 0; ks < 2; ++ks) ya[ks] = *(const bf16x8*)(sc + (p * 16 + lr) * 64 + ks * 32 + kg * 8);
#pragma unroll
        for (int qi = 0; qi < 2; ++qi)
#pragma unroll
            for (int ks = 0; ks < 2; ++ks) xb[qi][ks] = *(const bf16x8*)(qc + ((q0 + qi) * 16 + lr) * 64 + ks * 32 + kg * 8);
#pragma unroll
        for (int qi = 0; qi < 2; ++qi) { const int t2 = (q0 + qi) * 16 + lr, i2 = p * 16 + kg * 4;
            const u32x2 yw = *(const u32x2*)(yi + t2 * 64 + i2); f32x4 acc = (f32x4){blo(yw.x), bhi(yw.x), blo(yw.y), bhi(yw.y)};
#pragma unroll
            for (int ks = 0; ks < 2; ++ks) acc = __builtin_amdgcn_mfma_f32_16x16x32_bf16(ya[ks], xb[qi][ks], acc, 0, 0, 0);
            *(LAS f32x4*)(yb + t2 * 68 + i2) = acc; }
    }
    __syncthreads();
    { const u32x4 vs = shfl_up8(vc); if (!first) vp = vs; }
    const f32x4 y0 = *(const LAS f32x4*)(yb + t * 68 + c0), y1 = *(const LAS f32x4*)(yb + t * 68 + c0 + 4);
    float v[8], vq[8], g[8], y[8];
    v[0] = blo(vc.x); v[1] = bhi(vc.x); v[2] = blo(vc.y); v[3] = bhi(vc.y); v[4] = blo(vc.z); v[5] = bhi(vc.z); v[6] = blo(vc.w); v[7] = bhi(vc.w);
    vq[0] = blo(vp.x); vq[1] = bhi(vp.x); vq[2] = blo(vp.y); vq[3] = bhi(vp.y); vq[4] = blo(vp.z); vq[5] = bhi(vp.z); vq[6] = blo(vp.w); vq[7] = bhi(vp.w);
    g[0] = blo(gw4.x); g[1] = bhi(gw4.x); g[2] = blo(gw4.y); g[3] = bhi(gw4.y); g[4] = blo(gw4.z); g[5] = bhi(gw4.z); g[6] = blo(gw4.w); g[7] = bhi(gw4.w);
#pragma unroll
    for (int e = 0; e < 4; ++e) { y[e] = y0[e]; y[4 + e] = y1[e]; }
    float sy = 0.f;
#pragma unroll
    for (int e = 0; e < 8; ++e) { v[e] = v[e] + (vq[e] - v[e]) * mix[PC_V + col + e]; sy += y[e]; }
    sy += __shfl_xor(sy, 1); sy += __shfl_xor(sy, 2); sy += __shfl_xor(sy, 4);
    const float mu = sy * (1.f / 64.f); float sq = 0.f;
#pragma unroll
    for (int e = 0; e < 8; ++e) { const float d = y[e] - mu; sq += d * d; }
    sq += __shfl_xor(sq, 1); sq += __shfl_xor(sq, 2); sq += __shfl_xor(sq, 4);
    const float rstd = rsqrtf(sq * (1.f / 64.f) + 64e-5f);
    float o[8];
#pragma unroll
    for (int e = 0; e < 8; ++e) o[e] = ((y[e] - mu) * rstd * ln_w[col + e] + ln_b[col + e] + sb * v[e]) * g[e];
    u32x4 w; w.x = pk2(o[0], o[1]); w.y = pk2(o[2], o[3]); w.z = pk2(o[4], o[5]); w.w = pk2(o[6], o[7]);
    *(u32x4*)(YR + row * C + col) = w;
}

#define XB_TMO      128
#define XB_XCNT(j)  (256  + 64 * (j))
#define XB_XSUB(j)  (1280 + 64 * (j))
#define XB_XGEN(j)  (2304 + 64 * (j))
#define XB_TOP      3328
#define XB_TOPGEN   3392
#define XCD_BAR_WORDS 3456
#define XB_SPIN_CAP (1u << 18)

__device__ __forceinline__ unsigned xb_ld(unsigned* p)              { return __hip_atomic_load(p, __ATOMIC_RELAXED, __HIP_MEMORY_SCOPE_AGENT); }
__device__ __forceinline__ unsigned xb_add(unsigned* p, unsigned v) { return __hip_atomic_fetch_add(p, v, __ATOMIC_RELAXED, __HIP_MEMORY_SCOPE_AGENT); }
__device__ __forceinline__ unsigned xb_xcc_id() { return (unsigned)__builtin_amdgcn_s_getreg((3 << 11) | 20) & 0xFu; }
#define XB_SPIN(cond, bar) do { unsigned _sp = 0; while (cond) { __builtin_amdgcn_s_sleep(1); \
    if ((++_sp & 255u) == 0u) { if (xb_ld(&(bar)[XB_TMO])) break; if (_sp > XB_SPIN_CAP) { atomicAdd(&(bar)[XB_TMO], 1u); break; } } } } while (0)

struct XcdBarrier {
    unsigned* bar; unsigned x;
    volatile LAS unsigned* st;
};

__device__ __forceinline__ XcdBarrier xcd_barrier_post(unsigned* bar, volatile LAS unsigned* st) {
    XcdBarrier b; b.bar = bar; b.x = xb_xcc_id(); b.st = st;
    if (threadIdx.x == 0) (void)xb_add(&bar[XB_XCNT(b.x)], 1u);
    return b;
}
__device__ __forceinline__ void xcd_barrier_complete(unsigned* bar, unsigned x, unsigned& nloc, unsigned& nx) {
    const unsigned G = gridDim.x * gridDim.y * gridDim.z;
    unsigned sum, cnt, mine, sp = 0u;
    for (;;) {
        sum = 0u; cnt = 0u; mine = 0u;
#pragma unroll
        for (unsigned j = 0; j < 16; ++j) { const unsigned c = xb_ld(&bar[XB_XCNT(j)]); sum += c; cnt += (c > 0u) ? 1u : 0u; mine = (j == x) ? c : mine; }
        if (sum == G) break;
        __builtin_amdgcn_s_sleep(1);
        if ((++sp & 255u) == 0u) { if (xb_ld(&bar[XB_TMO])) break; if (sp > XB_SPIN_CAP) { atomicAdd(&bar[XB_TMO], 1u); break; } }
    }
    nloc = mine > 0u ? mine : 1u; nx = cnt > 0u ? cnt : 1u;
}

__device__ __forceinline__ void xcd_barrier(const XcdBarrier& b, bool leader) {
    asm volatile("s_waitcnt vmcnt(0)" ::: "memory");
    __syncthreads();
    if (leader) {
        unsigned* bar = b.bar;
        __builtin_amdgcn_s_waitcnt(0);
        unsigned nloc = b.st[0], nx = b.st[1];
        if (nloc == 0u) { xcd_barrier_complete(bar, b.x, nloc, nx); b.st[0] = nloc; b.st[1] = nx; }
        const unsigned old = xb_add(&bar[XB_XSUB(b.x)], 1u);
        const unsigned gen = old / nloc;
        if (old + 1u == (gen + 1u) * nloc) {
            __builtin_amdgcn_fence(__ATOMIC_RELEASE, "agent");
            asm volatile("s_waitcnt vmcnt(0)" ::: "memory");
            const unsigned og = xb_add(&bar[XB_TOP], 1u);
            const unsigned tg = og / nx;
            if (og + 1u == (tg + 1u) * nx) xb_add(&bar[XB_TOPGEN], 1u);
            else XB_SPIN(xb_ld(&bar[XB_TOPGEN]) == tg, bar);
            __builtin_amdgcn_fence(__ATOMIC_ACQUIRE, "agent");
            xb_add(&bar[XB_XGEN(b.x)], 1u);
            asm volatile("s_waitcnt vmcnt(0)" ::: "memory");
        } else {
            XB_SPIN(xb_ld(&bar[XB_XGEN(b.x)]) == gen, bar);
            __builtin_amdgcn_fence(__ATOMIC_ACQUIRE, "agent");
            asm volatile("s_waitcnt vmcnt(0)" ::: "memory");
        }
    }
    __syncthreads();
}

template <int MODE> struct EpiResNorm {
    static constexpr bool PERM = false, AFTER_DRAIN = true;
    const float* base; float* x1out; const float* gate; float* rowss; const float* gain; const float* mod; bf16* Hout; float* fout; unsigned* bar;
    __device__ __forceinline__ void fused(pg8::f32x4 (&acc)[2][2][4][2], const pg8::Unit& u, int wr, int wc, int fr, int fq, LAS unsigned char* lds, int wid, int lane) const {
        const int row0 = u.pm * 256 + wr * 64 + fr, bt = u.pm >> 4, c0 = u.pn * 256 + wc * 32 + 4 * fq; const float* gt = gate + bt * MODW;
#pragma unroll
        for (int bj = 0; bj < 2; ++bj)
#pragma unroll
            for (int n = 0; n < 2; ++n) { const int cc = c0 + bj * 128 + 16 * n; const f32x4 g = *(const f32x4*)(gt + cc);
#pragma unroll
                for (int ai = 0; ai < 2; ++ai) {
#pragma unroll
                    for (int m = 0; m < 4; ++m) { const size_t off = (size_t)(row0 + ai * 128 + m * 16) * D + cc;
                        const f32x4 bs = *(const f32x4*)(base + off); const f32x4 a = bs + g * acc[ai][bj][m][n]; acc[ai][bj][m][n] = a; asm volatile("" : "+v"(acc[ai][bj][m][n]));
                        if (MODE == 0) *(f32x4*)(x1out + off) = a;
                        if (m & 1) asm volatile("" ::: "memory"); } } }
#pragma unroll
        for (int ai = 0; ai < 2; ++ai)
#pragma unroll
            for (int m = 0; m < 4; ++m) { float s = 0.f;
#pragma unroll
                for (int bj = 0; bj < 2; ++bj)
#pragma unroll
                    for (int n = 0; n < 2; ++n) { const f32x4 a = acc[ai][bj][m][n]; s += (a[0] * a[0] + a[1] * a[1]) + (a[2] * a[2] + a[3] * a[3]); }
                s += __shfl_xor(s, 16); s += __shfl_xor(s, 32);
                if (fq == 0) (void)__hip_atomic_fetch_add(rowss + row0 + ai * 128 + m * 16, s, __ATOMIC_RELAXED, __HIP_MEMORY_SCOPE_AGENT); }
        { XcdBarrier xb; xb.bar = bar; xb.x = xb_xcc_id(); xb.st = (volatile LAS unsigned*)(lds + 131072); xcd_barrier(xb, wid == 0 && lane == 0); }
        int row0b = row0, c0b = c0; asm volatile("" : "+v"(row0b), "+v"(c0b));
#pragma unroll
        for (int ai = 0; ai < 2; ++ai)
#pragma unroll
            for (int m = 0; m < 4; ++m) { const int row = row0b + ai * 128 + m * 16;
                const float ss = __hip_atomic_load(rowss + row, __ATOMIC_RELAXED, __HIP_MEMORY_SCOPE_AGENT); const float rstd = rsqrtf(ss * (1.f / D) + 1e-6f);
#pragma unroll
                for (int bj = 0; bj < 2; ++bj)
#pragma unroll
                    for (int n = 0; n < 2; ++n) { const int cc = c0b + bj * 128 + 16 * n; const f32x4 gn = *(const f32x4*)(gain + cc); f32x4 o = acc[ai][bj][m][n] * rstd * gn;
                        if (MODE == 0) { const f32x4 sc = *(const f32x4*)(mod + bt * MODW + 4 * D + cc), sh = *(const f32x4*)(mod + bt * MODW + 3 * D + cc); o = o * (sc + 1.f) + sh;
                            u32x2 w; w.x = pk2(o[0], o[1]); w.y = pk2(o[2], o[3]); *(u32x2*)(Hout + (size_t)row * D + cc) = w; }
                        else *(f32x4*)(fout + (size_t)row * D + cc) = o; }
                asm volatile("" ::: "memory"); }
    }
};

__global__ void __launch_bounds__(512, 2) fwd(Args a) {
    extern __shared__ __attribute__((aligned(16))) unsigned char lds_raw[];
    cg::grid_group grid = cg::this_grid();
    LAS unsigned char* lds = (LAS unsigned char*)lds_raw;
    typedef const __attribute__((address_space(4))) Args* KArgs;
    const int G = gridDim.x, bx = blockIdx.x, NGW = G * 8, NT = G * 512;
    { volatile LAS unsigned* stz = (volatile LAS unsigned*)(lds + 131072); if (threadIdx.x < 64) stz[threadIdx.x] = 0u;
      if ((threadIdx.x & 63) == 0) ((volatile LAS int*)(lds + TID_TAB_OFF))[(unsigned)__builtin_amdgcn_s_getreg(0x2804) & 63u] = (int)(threadIdx.x >> 6); }
    __syncthreads();
    if (__builtin_expect(((KArgs)__builtin_amdgcn_kernarg_segment_ptr())->ph_hi == 0x7fffffff, 0)) grid.sync();
    (void)xcd_barrier_post((unsigned*)(((KArgs)__builtin_amdgcn_kernarg_segment_ptr())->ws), (volatile LAS unsigned*)(lds + 131072));
    const KArgs kp0 = (KArgs)__builtin_amdgcn_kernarg_segment_ptr();
#define PHASE_PTRS() KArgs kp; asm volatile("" : "=s"(kp) : "0"(kp0)); unsigned char* ws = kp->ws; (void)ws; \
    const int lane = get_lane(), wave = get_wave(lds), tid = wave * 64 + lane, gw = bx * 8 + wave, gt = bx * 512 + tid; (void)lane; (void)gw; (void)gt
#define MOD ((float*)(ws + WS_MOD))
#define BIASP ((float*)(ws + WS_BIASP))
#define WLORA ((bf16*)(ws + WS_WLORA))
#define WIN ((bf16*)(ws + WS_WIN))
#define WBR ((bf16*)(ws + WS_WBR))
#define WBA ((bf16*)(ws + WS_WBA))
#define WOUT ((bf16*)(ws + WS_WOUT))
#define WUP ((bf16*)((unsigned char*)AOUT + 32 * MiB))
#define TMPB ((bf16*)(ws + 8 * MiB))
#define WDOWN ((bf16*)(ws + WS_WDOWN))
#define YATT ((bf16*)(ws + WS_WL + 16 * MiB))
#define YR ((bf16*)(ws + WS_YR))
#define H ((bf16*)(ws + WS_H))
#define YRAW ((float*)(ws + WS_H))
#define MG ((bf16*)(ws + WS_H))
#define P ((bf16*)(ws + WS_P))
#define U ((bf16*)(ws + WS_P))
#define AL ((bf16*)(ws + WS_AL))
#define WL ((float*)(ws + WS_WL))
#define AS ((float*)(ws + WS_AS))
#define X1 ((float*)(ws + WS_WL))
#define GG ((bf16*)(ws + WS_GG))
#define MCB ((bf16*)(ws + 8 * MiB))
#define QCB ((bf16*)(ws + 24 * MiB))
#define NCB ((float*)(ws + 60 * MiB))
#define SCB ((bf16*)(ws + WS_WL))
#define LBIAS ((float*)(ws + WS_BIASP + 64 * 1024))
#define ROWSS ((float*)(ws + WS_MOD + 256 * 1024))
#define BONB ((float*)(ws + 128 * 1024))
#define AIN(k) (kp->in[k])
#define AOUT (kp->out)
#if N_LAUNCH_SPLIT
    const int lo = kp0->ph_lo, hi = kp0->ph_hi;
#else
    constexpr int lo = 0, hi = 14;
#endif
#ifndef PHMASK
#define PHMASK 0x3fff
#endif
#define IN(k) (((PHMASK >> (k)) & 1) && lo <= (k) && (k) < hi)
#ifndef DUPMASK
#define DUPMASK 0
#endif
#ifndef EXTRA_SYNCS
#define EXTRA_SYNCS 0
#endif
#define XBAR_NOW() ({ XcdBarrier xb_; KArgs kq_; asm volatile("" : "=s"(kq_) : "0"(kp0)); xb_.bar = (unsigned*)kq_->ws; xb_.x = xb_xcc_id(); xb_.st = (volatile LAS unsigned*)(lds + 131072); xb_; })
#define SEAM(k) do { if (IN(k) && IN((k) + 1)) xcd_barrier(XBAR_NOW(), get_wave(lds) == 0 && get_lane() == 0); } while (0)
#define REP(k) for (int rep_ = 0; rep_ < 1 + ((DUPMASK >> (k)) & 1); ++rep_, (void)(((DUPMASK >> (k)) & 1) && rep_ == 1 ? (xcd_barrier(XBAR_NOW(), get_wave(lds) == 0 && get_lane() == 0), 0) : 0))

    REP(0) if (IN(0)) { PHASE_PTRS();
        if (bx < 192) {
            const float* w_ada = AIN(2); const float* cvec = AIN(1); const float* b_ada = AIN(3);
            const int col0 = bx * 64, kr = tid >> 4, cq = tid & 15;
            f32x4 a0 = (f32x4){0.f, 0.f, 0.f, 0.f}, a1 = a0;
#pragma unroll 4
            for (int k = kr; k < D; k += 32) { const f32x4 w = *(const f32x4*)(w_ada + (size_t)k * MODW + col0 + cq * 4); float c0 = cvec[k], c1 = cvec[D + k]; c0 = c0 * sigm(c0); c1 = c1 * sigm(c1); a0 += c0 * w; a1 += c1 * w; }
            LAS f32x4* red = (LAS f32x4*)lds; red[(kr * 16 + cq) * 2] = a0; red[(kr * 16 + cq) * 2 + 1] = a1;
            __syncthreads();
            if (tid < 128) { const int b = tid >> 6, cc = tid & 63; const LAS float* rf = (const LAS float*)lds; float s = 0.f;
                for (int k2 = 0; k2 < 32; ++k2) s += rf[(k2 * 16 + (cc >> 2)) * 8 + b * 4 + (cc & 3)];
                MOD[b * MODW + col0 + cc] = s + b_ada[col0 + cc]; }
            __syncthreads();
        }
        LAS float* scr = (LAS float*)(lds + wave * 8448);
        const float* w_in = AIN(5);
        constexpr int I1 = 32 * 105, I2 = 32 * 40, I3 = 32 * 128, I4 = 16 * 64, I5 = 16 * 64, I6 = 32 * 64;
        for (int it = gw; it < I1 + I2 + I3; it += NGW) {
            int r = it;
            if (r < I1) { transpose_item(w_in, 8736, 0, WIN, D, 0, r / 105, r % 105, scr, lane); continue; } r -= I1;
            if (r < I2) { transpose_item(w_in, 8736, 3360, WIN, D, PC_Q, r / 40, r % 40, scr, lane); continue; } r -= I2;
            transpose_item(w_in, 8736, 4640, WIN, D, PC_GR, r / 128, r % 128, scr, lane);
        }
        (void)I4; (void)I5; (void)I6;
        const float* b_in = AIN(6);
        for (int i = gt; i < NIN; i += NT) { float v = 0.f; if (i < 3360) v = b_in[i]; else if (i >= PC_Q && i < PC_GR) v = b_in[3360 + i - PC_Q]; else if (i >= PC_GR) v = b_in[4640 + i - PC_GR]; BIASP[i] = v; }
        for (int i = gt; i < 2 * M; i += NT) ROWSS[i] = 0.f;
        for (int i = gt; i < 2 * C; i += NT) LBIAS[i] = i < C ? AIN(8)[i] : AIN(10)[i - C];
        for (int i = gt; i < 224 * D / 8; i += NT) *(u32x4*)(WIN + (size_t)3360 * D + (size_t)i * 8) = (u32x4){0u, 0u, 0u, 0u};
        const float* w2 = AIN(9); const float* a2 = AIN(11); const float* g2 = AIN(12);
        for (int i = gt; i < 3072 * 48; i += NT) { const int n = i / 48, k0 = (i % 48) * 8; float v[8];
#pragma unroll
            for (int e = 0; e < 8; ++e) { const int k = k0 + e; float t = 0.f;
                if (n < 1024) { if (k < 64) t = w2[k * C + n]; } else if (n < 2048) { if (k >= 64 && k < 128) t = a2[(k - 64) * C + n - 1024]; } else { if (k >= 128 && k < 288) t = g2[(k - 128) * C + n - 2048]; }
                v[e] = t; }
            u32x4 o; o.x = pk2(v[0], v[1]); o.y = pk2(v[2], v[3]); o.z = pk2(v[4], v[5]); o.w = pk2(v[6], v[7]);
            *(u32x4*)(WLORA + (size_t)n * KL + k0) = o; }
    }
    SEAM(0);
    for (int es_ = 0; es_ < EXTRA_SYNCS; ++es_) xcd_barrier(XBAR_NOW(), get_wave(lds) == 0 && get_lane() == 0);
    REP(1) if (IN(1)) { PHASE_PTRS(); norm_rows_bf16(AIN(0), AIN(4), MOD, D, 0, H, gw, NGW, lane); }
    SEAM(1);
    REP(2) if (IN(2)) { PHASE_PTRS(); pg8::Gemm g{H, WIN, M, NIN, D}; pg8::StaticOrder S; S.init(M, NIN, G, bx); EpiIn E{P, BIASP};
        pg8::gemm_phase<EpiIn, pg8::StaticOrder, true, true>(lds, g, S, E);
        const int nfull = (M / 256) * (NIN / 256) - ((M / 256) * (NIN / 256) / G) * G;
        if (bx >= nfull) { LAS float* scr = (LAS float*)(lds + wave * 8448);
            for (int it = (bx - nfull) * 8 + wave; it < 32 * 256 + 128 * 64; it += (G - nfull) * 8) {
                if (it < 32 * 256) transpose_item(AIN(23), FF, 0, WUP, D, 0, it / 256, it % 256, scr, lane);
                else { const int r = it - 32 * 256; transpose_item(AIN(24), D, 0, WDOWN, FF, 0, r / 64, r % 64, scr, lane); } } } }
    SEAM(2);
    REP(3) if (IN(3)) { PHASE_PTRS();
        const float* mix = AIN(7);
        for (int idx = gt; idx < M * 48; idx += NT) { const int m = idx / 48, ch = idx % 48; u32x4 o = (u32x4){0u, 0u, 0u, 0u};
            if (ch < 36) { const int col = PC_LORA + ch * 8; const u32x4 cw = *(const u32x4*)(P + (size_t)m * NIN + col); u32x4 pw = (u32x4){0u, 0u, 0u, 0u};
                if (m & (T - 1)) pw = *(const u32x4*)(P + (size_t)(m - 1) * NIN + col);
                float cv[8], pv[8];
                cv[0] = blo(cw.x); cv[1] = bhi(cw.x); cv[2] = blo(cw.y); cv[3] = bhi(cw.y); cv[4] = blo(cw.z); cv[5] = bhi(cw.z); cv[6] = blo(cw.w); cv[7] = bhi(cw.w);
                pv[0] = blo(pw.x); pv[1] = bhi(pw.x); pv[2] = blo(pw.y); pv[3] = bhi(pw.y); pv[4] = blo(pw.z); pv[5] = bhi(pw.z); pv[6] = blo(pw.w); pv[7] = bhi(pw.w);
#pragma unroll
                for (int e = 0; e < 8; ++e) { float p = cv[e] + (pv[e] - cv[e]) * mix[col + e];
                    if (ch < 8) p = 1.f - 2.f / (1.f + __expf(2.f * p)); else if (ch >= 16) p = sigm(p);
                    cv[e] = p; }
                o.x = pk2(cv[0], cv[1]); o.y = pk2(cv[2], cv[3]); o.z = pk2(cv[4], cv[5]); o.w = pk2(cv[6], cv[7]); }
            *(u32x4*)(AL + (size_t)m * KL + ch * 8) = o; }
    }
    SEAM(3);
    REP(4) if (IN(4)) { PHASE_PTRS(); pg8::Gemm g{AL, WLORA, M, 3072, KL}; pg8::StaticOrder S; S.init(M, 3072, G, bx); EpiLora E{WL, GG, LBIAS};
        pg8::gemm_phase<EpiLora, pg8::StaticOrder, true, true>(lds, g, S, E);
        const int nfull = 384 - (384 / G) * G;
        if (bx >= nfull) { LAS float* scr = (LAS float*)(lds + wave * 8448);
            for (int it = (bx - nfull) * 8 + wave; it < 16 * 64 + 16 * 64 + 32 * 64; it += (G - nfull) * 8) { int r = it;
                if (r < 16 * 64) { transpose_item(AIN(19), D, 0, WBR, C, 0, r / 64, r % 64, scr, lane); continue; } r -= 16 * 64;
                if (r < 16 * 64) { transpose_item(AIN(20), D, 0, WBA, C, 0, r / 64, r % 64, scr, lane); continue; } r -= 16 * 64;
                transpose_item(AIN(21), D, 0, WOUT, D, 0, r / 64, r % 64, scr, lane); } } }
    SEAM(4);
    REP(5) if (IN(5)) { PHASE_PTRS();
        ChunkRaw raw = chunk_load_raw(P, WL, AS, bx, tid);
        for (int q = bx; q < 2048; q += G) {
            chunk_pass_a_prep(raw, AIN(7), AIN(13), AIN(14), AIN(15), BONB, q, lds, tid);
            asm volatile("" ::: "memory");
            if (q + G < 2048) raw = chunk_load_raw(P, WL, AS, q + G, tid);
            chunk_pass_a_mm(MCB, QCB, NCB, (float*)AOUT, q, lds, tid);
        }
    }
    SEAM(5);
    REP(6) if (IN(6)) { PHASE_PTRS();
        if (bx < 128) { if (wave == 0) chunk_pass_b(MCB, NCB, SCB, bx >> 2, bx & 3, lane, (volatile LAS int*)(lds + 131072 + 256)); }
        else for (int u = bx - 128; u < 256; u += G - 128) attn_unit(P, AIN(18), YATT, u, lds, tid);
    }
    SEAM(6);
    REP(7) if (IN(7)) { PHASE_PTRS();
        { int it = 0; for (int q = bx; q < 2048; q += G, ++it) chunk_pass_c_fin(QCB, SCB, (const float*)AOUT, P, BONB, GG, AIN(7), AIN(16), AIN(17), YR, q, it, lds, tid, wave, lane); }
    }
    SEAM(7);
    REP(9) if (IN(9)) { PHASE_PTRS();
        { pg8::Gemm g{YR, WBR, M, D, C}; pg8::StaticOrder S; S.init(M, D, G, bx); EpiBr<0> E{P, TMPB, MG};
          pg8::gemm_phase<EpiBr<0>, pg8::StaticOrder, true, true>(lds, g, S, E); }
        { pg8::Gemm g{YATT, WBA, M, D, C}; pg8::StaticOrder S; S.init(M, D, G, bx); EpiBr<1> E{P, TMPB, MG};
          pg8::gemm_phase<EpiBr<1>, pg8::StaticOrder, true, true>(lds, g, S, E); }
    }
    SEAM(9);
    REP(10) if (IN(10)) { PHASE_PTRS();
        pg8::Gemm g{MG, WOUT, M, D, D}; pg8::StaticOrder S; S.init(M, D, G, bx); EpiResNorm<0> E{AIN(0), X1, MOD + 2 * D, ROWSS, AIN(22), MOD, H, nullptr, (unsigned*)ws};
        pg8::gemm_phase<EpiResNorm<0>, pg8::StaticOrder, false, true>(lds, g, S, E); }
    SEAM(10);
    REP(12) if (IN(12)) { PHASE_PTRS(); pg8::Gemm g{H, WUP, M, FF, D}; pg8::StaticOrder S; S.init(M, FF, G, bx); EpiUp E{U};
        pg8::gemm_phase<EpiUp, pg8::StaticOrder, true, true>(lds, g, S, E); }
    SEAM(12);
    REP(13) if (IN(13)) { PHASE_PTRS(); pg8::Gemm g{U, WDOWN, M, D, FF}; pg8::StaticOrder S; S.init(M, D, G, bx); EpiResNorm<1> E{X1, nullptr, MOD + 5 * D, ROWSS + M, AIN(25), MOD, nullptr, AOUT, (unsigned*)ws};
        pg8::gemm_phase<EpiResNorm<1>, pg8::StaticOrder, false, true>(lds, g, S, E); }
#undef IN
#undef SEAM
}

extern "C" void kernel_launch(void* const* d_in, const int* in_sizes, int n_in, void* d_out, int out_size, void* d_ws, size_t ws_size, hipStream_t stream) {
    static int grid = 0;
    if (grid == 0) {
        int dev = 0, cus = 0, per_cu = 0;
        hipGetDevice(&dev);
        hipDeviceGetAttribute(&cus, hipDeviceAttributeMultiprocessorCount, dev);
        hipFuncSetAttribute((const void*)fwd, hipFuncAttributeMaxDynamicSharedMemorySize, LDS_BYTES);
        hipOccupancyMaxActiveBlocksPerMultiprocessor(&per_cu, (const void*)fwd, 512, LDS_BYTES);
        if (per_cu < 1) { fprintf(stderr, "kernel_launch: occupancy query says %d blocks per CU\n", per_cu); per_cu = 1; }
        if (per_cu > 1) per_cu = 1;
        grid = cus * per_cu;
        if (grid > 256) grid = 256;
        (void)hipGetLastError();
    }
    (void)hipMemsetAsync(d_ws, 0, 16384, stream);
    Args a{};
    for (int i = 0; i < 26; ++i) a.in[i] = (const float*)d_in[i];
    a.out = (float*)d_out; a.ws = (unsigned char*)d_ws;
#if N_LAUNCH_SPLIT
    for (int p = 0; p < 14; ++p) { a.ph_lo = p; a.ph_hi = p + 1; hipLaunchKernelGGL(fwd, dim3(grid), dim3(512), LDS_BYTES, stream, a); }
#else
    a.ph_lo = 0; a.ph_hi = 14;
    void* args[] = {&a};
    hipError_t e = hipLaunchCooperativeKernel((const void*)fwd, dim3(grid), dim3(512), args, LDS_BYTES, stream);
    if (e != hipSuccess) fprintf(stderr, "cooperative launch failed: %s (grid %d)\n", hipGetErrorString(e), grid);
#endif
}
```

```cpp
#include <hip/hip_runtime.h>
#include <hip/hip_cooperative_groups.h>
#include <cstdio>
#include <cstdint>
namespace cg = cooperative_groups;
__device__ __forceinline__ int pg8_get_lane() { int l; asm volatile("v_mbcnt_lo_u32_b32 %0, -1, 0\n\tv_mbcnt_hi_u32_b32 %0, -1, %0" : "=v"(l)); return l; }
__device__ __forceinline__ int pg8_get_wave(__attribute__((address_space(3))) unsigned char* lds) { const unsigned hw = (unsigned)__builtin_amdgcn_s_getreg(0x2804) & 63u; const int w = ((volatile __attribute__((address_space(3))) int*)(lds + 131072 + 512))[hw]; return __builtin_amdgcn_readfirstlane(w); }
namespace pg8 {
#define PG8_LAS __attribute__((address_space(3)))
typedef unsigned short bf16_t;
typedef short bf16x8 __attribute__((ext_vector_type(8)));
typedef float f32x4 __attribute__((ext_vector_type(4)));
typedef unsigned u32x4 __attribute__((ext_vector_type(4)));
constexpr int BM = 256, BK = 64, HALF = 128, HTB = HALF * BK * 2  , STAGE_BYTES = 8 * HTB, NXCD = 8, WGM = 4;

__host__ __device__ __forceinline__ int lds_byte(int r, int c) { const int st = (r >> 4) * 2 + (c >> 5), rr = r & 15, cc = c & 31, ob = rr * 64 + cc * 2; return st * 1024 + (ob ^ (((ob >> 9) & 1) << 5)); }
__host__ __device__ __forceinline__ void stage_rc(int b, int& R, int& C) { const int st = b / 1024, sb = b % 1024, swz = sb ^ (((sb >> 9) & 1) << 5); R = (st >> 1) * 16 + swz / 64; C = (st & 1) * 32 + (swz % 64) / 2; }
__host__ __device__ __forceinline__ int perm32(int rho) { const int n = rho >> 4, i = rho & 15; return 8 * (i >> 2) + 4 * n + (i & 3); }

struct Unit { int pm, pn; };
struct Gemm { const bf16_t* A; const bf16_t* Bt; int M, N, K; };
struct StaticOrder {
    int nM, nN, nwg, G, c;
    __host__ __device__ void init(int M, int N, int G_, int c_) { nM = M / BM; nN = N / BM; nwg = nM * nN; G = G_; c = c_; }
    __host__ __device__ bool next(int i, Unit& u) const {
        const long L = (long)i * G + c; if (L >= nwg) return false;
        int wgid = (int)L; { const int q = nwg / NXCD, r = nwg % NXCD, xcd = wgid % NXCD, off = wgid / NXCD; wgid = (xcd < r ? xcd * (q + 1) : r * (q + 1) + (xcd - r) * q) + off; }
        const int nig = WGM * nN, gid = wgid / nig, fm = gid * WGM, gsz = (nM - fm) < WGM ? (nM - fm) : WGM;
        u.pm = fm + ((wgid % nig) % gsz); u.pn = (wgid % nig) / gsz; return true;
    }
    __device__ __forceinline__ void a_ready(const Unit&) const {}
    __device__ __forceinline__ void done(const Unit&) const {}
};

__device__ __forceinline__ unsigned cvt_pk_bf16(float lo, float hi) { unsigned r; asm volatile("v_cvt_pk_bf16_f32 %0, %1, %2" : "=v"(r) : "v"(lo), "v"(hi)); return r; }
typedef float f32x2 __attribute__((ext_vector_type(2)));
template <class Epi, class Sched, bool ALIGN_EPI = false, bool SP2 = false>
__device__ __forceinline__ void gemm_phase(PG8_LAS unsigned char* lds, const Gemm g, const Sched& S, const Epi& E) {
    const int lane = pg8_get_lane(), wid = pg8_get_wave(lds), tid = wid * 64 + lane;
    const int wr = wid >> 2, wc = wid & 3, fr = lane & 15, fq = lane >> 4;
    const int K = g.K, nt = K / BK;
    unsigned voffA[2], voffB[2];
#pragma unroll
    for (int i = 0; i < 2; ++i) { int R, C; stage_rc(tid * 16 + i * 8192, R, C); const int Rb = Epi::PERM ? ((R & ~31) + perm32(R & 31)) : R;
        voffA[i] = (unsigned)(R * K + C) * 2u; voffB[i] = (unsigned)(Rb * K + C) * 2u; }
    const size_t kstep = (size_t)(BK * 2);
    const size_t hstep = (size_t)HALF * K * 2;
    const size_t tstep = 2 * hstep;
    const unsigned ldsw = (unsigned)wid * 1024u;
    const int aoff = lds_byte(wr * 64 + fr, fq * 8), boff = lds_byte(wc * 32 + fr, fq * 8);
#define PG8_SA(b, h) (((b) * 2 + (h)) * HTB)
#define PG8_SB(b, h) ((4 + (b) * 2 + (h)) * HTB)
#define PG8_STAGE(bufoff, gbase, voff) do { _Pragma("unroll") for (int _i = 0; _i < 2; ++_i) \
        __builtin_amdgcn_global_load_lds((const unsigned*)((const char*)(gbase) + (voff)[_i]), (PG8_LAS unsigned*)(lds + (bufoff) + ldsw + _i * 8192), 16, 0, 0); } while (0)
#define PG8_LDA(dst, b, h) do { _Pragma("unroll") for (int m = 0; m < 4; ++m) _Pragma("unroll") for (int k = 0; k < 2; ++k) dst[m][k] = *(const PG8_LAS bf16x8*)(lds + PG8_SA(b, h) + aoff + m * 2048 + k * 1024); } while (0)
#define PG8_LDB(dst, b, h) do { _Pragma("unroll") for (int n = 0; n < 2; ++n) _Pragma("unroll") for (int k = 0; k < 2; ++k) dst[n][k] = *(const PG8_LAS bf16x8*)(lds + PG8_SB(b, h) + boff + n * 2048 + k * 1024); } while (0)
#define PG8_MMA(ai, bj, At, Bt) do { __builtin_amdgcn_s_setprio(1); _Pragma("unroll") for (int m = 0; m < 4; ++m) _Pragma("unroll") for (int n = 0; n < 2; ++n) _Pragma("unroll") for (int k = 0; k < 2; ++k) \
        acc[ai][bj][m][n] = __builtin_amdgcn_mfma_f32_16x16x32_bf16(Bt[n][k], At[m][k], acc[ai][bj][m][n], 0, 0, 0); __builtin_amdgcn_s_setprio(0); } while (0)
#define PG8_WAIT_V(n) asm volatile("s_waitcnt vmcnt(" #n ")" ::: "memory")
#define PG8_WAIT_L(n) asm volatile("s_waitcnt lgkmcnt(" #n ")" ::: "memory")
#define PG8_BAR __builtin_amdgcn_s_barrier()
#define PG8_SCHED __builtin_amdgcn_sched_barrier(0)
    Unit cur, nxt; int ui = 0;
    if (!S.next(0, cur)) return;
    f32x4 acc[2][2][4][2];
#pragma unroll
    for (int a = 0; a < 2; ++a)
#pragma unroll
        for (int b = 0; b < 2; ++b)
#pragma unroll
            for (int m = 0; m < 4; ++m)
#pragma unroll
                for (int n = 0; n < 2; ++n) acc[a][b][m][n] = (f32x4){0.f, 0.f, 0.f, 0.f};
    bf16x8 At[4][2], B0[2][2], B1[2][2];
    const char* cA = (const char*)g.A + (size_t)cur.pm * tstep; const char* cB = (const char*)g.Bt + (size_t)cur.pn * tstep;
    S.a_ready(cur);
    if constexpr (SP2) {
        PG8_STAGE(PG8_SB(0, 0), cB, voffB); PG8_STAGE(PG8_SB(0, 1), cB + hstep, voffB); PG8_STAGE(PG8_SA(0, 0), cA, voffA); PG8_STAGE(PG8_SA(0, 1), cA + hstep, voffA);
        if (wr == 1) PG8_BAR;
        PG8_WAIT_V(2); PG8_BAR;
        PG8_STAGE(PG8_SB(1, 0), cB + kstep, voffB); PG8_STAGE(PG8_SA(1, 0), cA + kstep, voffA); PG8_STAGE(PG8_SB(1, 1), cB + hstep + kstep, voffB);
        PG8_WAIT_V(6); PG8_BAR;
    } else {
        PG8_STAGE(PG8_SB(0, 0), cB, voffB); PG8_STAGE(PG8_SA(0, 0), cA, voffA); PG8_STAGE(PG8_SB(0, 1), cB + hstep, voffB); PG8_STAGE(PG8_SA(0, 1), cA + hstep, voffA);
        if (wr == 1) PG8_BAR;
        PG8_WAIT_V(4); PG8_BAR;
        PG8_STAGE(PG8_SB(1, 0), cB + kstep, voffB); PG8_STAGE(PG8_SA(1, 0), cA + kstep, voffA); PG8_STAGE(PG8_SB(1, 1), cB + hstep + kstep, voffB);
        PG8_WAIT_V(6); PG8_BAR;
    }
    for (;;) {
        const bool has_next = S.next(ui + 1, nxt);
        const char* nA = has_next ? (const char*)g.A + (size_t)nxt.pm * tstep : cA; const char* nB = has_next ? (const char*)g.Bt + (size_t)nxt.pn * tstep : cB;
        for (int t = 0; t < nt; t += 2) {
            const bool last = (t == nt - 2);
            const char* a1 = cA + (size_t)(t + 1) * kstep;
            const char* a2 = last ? nA : cA + (size_t)(t + 2) * kstep; const char* b2 = last ? nB : cB + (size_t)(t + 2) * kstep;
            const char* a3 = a2 + kstep; const char* b3 = b2 + kstep;
            if (last && has_next) S.a_ready(nxt);
            if constexpr (SP2) {
            PG8_LDB(B0, 0, 0); PG8_LDB(B1, 0, 1); PG8_SCHED; PG8_LDA(At, 0, 0); PG8_STAGE(PG8_SA(1, 1), a1 + hstep, voffA);
            PG8_WAIT_V(8); PG8_WAIT_L(0); PG8_BAR; PG8_MMA(0, 0, At, B0); PG8_MMA(0, 1, At, B1); PG8_BAR; PG8_SCHED;
            PG8_LDA(At, 0, 1); PG8_STAGE(PG8_SB(0, 0), b2, voffB); PG8_STAGE(PG8_SB(0, 1), b2 + hstep, voffB); PG8_STAGE(PG8_SA(0, 0), a2, voffA);
            PG8_WAIT_V(8); PG8_WAIT_L(0); PG8_BAR; PG8_MMA(1, 0, At, B0); PG8_MMA(1, 1, At, B1); PG8_BAR; PG8_SCHED;
            PG8_LDB(B0, 1, 0); PG8_LDB(B1, 1, 1); PG8_SCHED; PG8_LDA(At, 1, 0); PG8_STAGE(PG8_SA(0, 1), a2 + hstep, voffA);
            PG8_WAIT_V(8); PG8_WAIT_L(0); PG8_BAR; PG8_MMA(0, 0, At, B0); PG8_MMA(0, 1, At, B1); PG8_BAR; PG8_SCHED;
            PG8_LDA(At, 1, 1); PG8_STAGE(PG8_SB(1, 0), b3, voffB); PG8_STAGE(PG8_SB(1, 1), b3 + hstep, voffB); PG8_STAGE(PG8_SA(1, 0), a3, voffA);
            PG8_WAIT_V(8); PG8_WAIT_L(0); PG8_BAR; PG8_MMA(1, 0, At, B0); PG8_MMA(1, 1, At, B1); PG8_BAR; PG8_SCHED;
            } else {
            PG8_LDB(B0, 0, 0); PG8_SCHED; PG8_LDA(At, 0, 0); PG8_STAGE(PG8_SA(1, 1), a1 + hstep, voffA);
            PG8_WAIT_L(8); PG8_BAR; PG8_WAIT_L(0); PG8_MMA(0, 0, At, B0); PG8_BAR; PG8_SCHED;
            PG8_LDB(B1, 0, 1); PG8_STAGE(PG8_SB(0, 0), b2, voffB);
            PG8_BAR; PG8_WAIT_L(0); PG8_MMA(0, 1, At, B1); PG8_BAR;
            PG8_LDA(At, 0, 1); PG8_STAGE(PG8_SA(0, 0), a2, voffA);
            PG8_BAR; PG8_WAIT_L(0); PG8_MMA(1, 0, At, B0); PG8_BAR; PG8_SCHED;
            PG8_STAGE(PG8_SB(0, 1), b2 + hstep, voffB);
            PG8_WAIT_V(6); PG8_BAR; PG8_MMA(1, 1, At, B1); PG8_BAR;
            PG8_LDB(B0, 1, 0); PG8_SCHED; PG8_LDA(At, 1, 0); PG8_STAGE(PG8_SA(0, 1), a2 + hstep, voffA);
            PG8_WAIT_L(8); PG8_BAR; PG8_WAIT_L(0); PG8_MMA(0, 0, At, B0); PG8_BAR; PG8_SCHED;
            PG8_LDB(B1, 1, 1); PG8_STAGE(PG8_SB(1, 0), b3, voffB);
            PG8_BAR; PG8_WAIT_L(0); PG8_MMA(0, 1, At, B1); PG8_BAR;
            PG8_LDA(At, 1, 1); PG8_STAGE(PG8_SA(1, 0), a3, voffA);
            PG8_BAR; PG8_WAIT_L(0); PG8_MMA(1, 0, At, B0); PG8_BAR; PG8_SCHED;
            PG8_STAGE(PG8_SB(1, 1), b3 + hstep, voffB);
            PG8_WAIT_V(6); PG8_BAR; PG8_MMA(1, 1, At, B1); PG8_BAR;
            }
        }
        if constexpr (ALIGN_EPI) { if (wr == 0) PG8_BAR; }
        if constexpr (!Epi::AFTER_DRAIN) { E(acc, cur, wr, wc, fr, fq); S.done(cur); }
        if (!has_next) break;
#pragma unroll
        for (int a = 0; a < 2; ++a)
#pragma unroll
            for (int b = 0; b < 2; ++b)
#pragma unroll
                for (int m = 0; m < 4; ++m)
#pragma unroll
                    for (int n = 0; n < 2; ++n) acc[a][b][m][n] = (f32x4){0.f, 0.f, 0.f, 0.f};
        cur = nxt; cA = nA; cB = nB; ++ui;
        if constexpr (ALIGN_EPI) { if (wr == 1) PG8_BAR; }
    }
    PG8_WAIT_V(0);
    if constexpr (!ALIGN_EPI) { if (wr == 0) PG8_BAR; }
    PG8_BAR;
    if constexpr (Epi::AFTER_DRAIN) { E.fused(acc, cur, wr, wc, fr, fq, lds, wid, lane); S.done(cur); }
#undef PG8_SA
#undef PG8_SB
#undef PG8_STAGE
#undef PG8_LDA
#undef PG8_LDB
#undef PG8_MMA
#undef PG8_WAIT_V
#undef PG8_WAIT_L
#undef PG8_BAR
#undef PG8_SCHED
}
}

#ifndef N_LAUNCH_SPLIT
#define N_LAUNCH_SPLIT 0
#endif
#define LAS __attribute__((address_space(3)))
#define TID_TAB_OFF (131072 + 512)
__device__ __forceinline__ int get_lane() { int l; asm volatile("v_mbcnt_lo_u32_b32 %0, -1, 0\n\tv_mbcnt_hi_u32_b32 %0, -1, %0" : "=v"(l)); return l; }
__device__ __forceinline__ int get_wave(LAS unsigned char* lds) { const unsigned hw = (unsigned)__builtin_amdgcn_s_getreg(0x2804) & 63u; const int w = ((volatile LAS int*)(lds + TID_TAB_OFF))[hw]; return __builtin_amdgcn_readfirstlane(w); }
typedef unsigned short bf16;
typedef float f32x4 __attribute__((ext_vector_type(4)));
typedef short bf16x8 __attribute__((ext_vector_type(8)));
typedef unsigned u32x4 __attribute__((ext_vector_type(4)));
typedef unsigned u32x2 __attribute__((ext_vector_type(2)));
#define LDS_WAIT() asm volatile("s_waitcnt lgkmcnt(0)" ::: "memory")

constexpr int NB = 2, T = 4096, D = 2048, M = NB * T, C = 1024, FF = 8192;
constexpr int NIN = 8960;
constexpr int PC_R = 0, PC_K = 1024, PC_V = 2048, PC_LORA = 3072, PC_Q = 3584, PC_AK = 4608, PC_AV = 4736, PC_GR = 4864, PC_GA = 6912;
constexpr int KL = 384;
constexpr int MODW = 6 * D;

constexpr size_t MiB = 1u << 20;
constexpr size_t WS_MOD = 1 * MiB, WS_BIASP = 1 * MiB + 512 * 1024, WS_WLORA = 2 * MiB;
constexpr size_t WS_WIN = 8 * MiB, WS_WBR = 44 * MiB, WS_WBA = 48 * MiB, WS_WOUT = 52 * MiB, WS_WUP = 60 * MiB, WS_WDOWN = 92 * MiB;
constexpr size_t WS_YATT = 60 * MiB, WS_YR = 76 * MiB;
constexpr size_t WS_H = 124 * MiB;
constexpr size_t WS_P = 156 * MiB;
constexpr size_t WS_AL = 296 * MiB;
constexpr size_t WS_WL = 302 * MiB, WS_AS = 334 * MiB;
constexpr size_t WS_GG = 366 * MiB;
constexpr int LDS_BYTES = 131072 + 1024;

struct Args { const float* in[26]; float* out; unsigned char* ws; int ph_lo, ph_hi; };

__device__ __forceinline__ float bf2f(unsigned b) { return __uint_as_float(b << 16); }
__device__ __forceinline__ unsigned f2bf(float f) { unsigned u = __float_as_uint(f); return (u + 0x7fffu + ((u >> 16) & 1u)) >> 16; }
__device__ __forceinline__ unsigned pk2(float lo, float hi) { return f2bf(lo) | (f2bf(hi) << 16); }
__device__ __forceinline__ float sigm(float x) { return __builtin_amdgcn_rcpf(1.0f + __builtin_amdgcn_exp2f(-1.44269504f * x)); }
__device__ __forceinline__ float blo(unsigned w) { return __uint_as_float(w << 16); }
__device__ __forceinline__ float bhi(unsigned w) { return __uint_as_float(w & 0xffff0000u); }
__device__ __forceinline__ float wave_sum(float v) {
#pragma unroll
    for (int o = 1; o < 64; o <<= 1) v += __shfl_xor(v, o);
    return v;
}
#define DPP_ADD(v, ctrl) v += __builtin_bit_cast(float, __builtin_amdgcn_update_dpp(0, __builtin_bit_cast(int, v), ctrl, 0xF, 0xF, true))
__device__ __forceinline__ float rowsum16(float v) {
    DPP_ADD(v, 0xB1); DPP_ADD(v, 0x4E); DPP_ADD(v, 0x141); DPP_ADD(v, 0x140);
    return v;
}

struct EpiIn {
    static constexpr bool PERM = true, AFTER_DRAIN = false;
    bf16* P; const float* bias;
    __device__ __forceinline__ void operator()(const pg8::f32x4 (&acc)[2][2][4][2], const pg8::Unit& u, int wr, int wc, int fr, int fq) const {
        const bool gate = u.pn >= 19; const int row0 = u.pm * 256 + wr * 64 + fr;
#pragma unroll
        for (int bj = 0; bj < 2; ++bj) {
            const int col = u.pn * 256 + bj * 128 + wc * 32 + 8 * fq;
            const f32x4 b0 = *(const f32x4*)(bias + col), b1 = *(const f32x4*)(bias + col + 4);
#pragma unroll
            for (int ai = 0; ai < 2; ++ai)
#pragma unroll
                for (int m = 0; m < 4; ++m) {
                    f32x4 v0 = acc[ai][bj][m][0] + b0, v1 = acc[ai][bj][m][1] + b1;
                    if (gate) { v0 = (f32x4){sigm(v0[0]), sigm(v0[1]), sigm(v0[2]), sigm(v0[3])}; v1 = (f32x4){sigm(v1[0]), sigm(v1[1]), sigm(v1[2]), sigm(v1[3])}; }
                    u32x4 w; w.x = pg8::cvt_pk_bf16(v0[0], v0[1]); w.y = pg8::cvt_pk_bf16(v0[2], v0[3]); w.z = pg8::cvt_pk_bf16(v1[0], v1[1]); w.w = pg8::cvt_pk_bf16(v1[2], v1[3]);
                    *(u32x4*)(P + (size_t)(row0 + ai * 128 + m * 16) * NIN + col) = w;
                }
        }
    }
};
struct EpiLora {
    static constexpr bool PERM = false, AFTER_DRAIN = false;
    float* WLAS; bf16* GG; const float* lbias;
    __device__ __forceinline__ void operator()(const pg8::f32x4 (&acc)[2][2][4][2], const pg8::Unit& u, int wr, int wc, int fr, int fq) const {
        const int typ = u.pn >> 2, cb = (u.pn & 3) * 256 + wc * 32 + 4 * fq, row0 = u.pm * 256 + wr * 64 + fr;
        if (typ < 2) {
            float* dst = WLAS + (size_t)typ * ((size_t)M * C) + cb; const float* bias = lbias + typ * C + cb; const float scale = typ == 0 ? -0.60653066f : 1.0f;
#pragma unroll
            for (int ai = 0; ai < 2; ++ai)
#pragma unroll
                for (int m = 0; m < 4; ++m) { float* drow = dst + (size_t)(row0 + ai * 128 + m * 16) * C;
#pragma unroll
                    for (int bj = 0; bj < 2; ++bj)
#pragma unroll
                        for (int n = 0; n < 2; ++n) { const f32x4 b = *(const f32x4*)(bias + bj * 128 + 16 * n);
                            const f32x4 x = acc[ai][bj][m][n] + b; const f32x4 o = (f32x4){sigm(x[0]), sigm(x[1]), sigm(x[2]), sigm(x[3])} * scale;
                            *(f32x4*)(drow + bj * 128 + 16 * n) = o; }
                    asm volatile("" ::: "memory"); }
        } else {
            bf16* dst = GG + cb;
#pragma unroll
            for (int ai = 0; ai < 2; ++ai)
#pragma unroll
                for (int m = 0; m < 4; ++m) { bf16* drow = dst + (size_t)(row0 + ai * 128 + m * 16) * C;
#pragma unroll
                    for (int bj = 0; bj < 2; ++bj)
#pragma unroll
                        for (int n = 0; n < 2; ++n) { const f32x4 x = acc[ai][bj][m][n]; u32x2 w; w.x = pg8::cvt_pk_bf16(x[0], x[1]); w.y = pg8::cvt_pk_bf16(x[2], x[3]);
                            *(u32x2*)(drow + bj * 128 + 16 * n) = w; }
                    asm volatile("" ::: "memory"); }
        }
    }
};
template <int MODE> struct EpiBr {
    static constexpr bool PERM = true, AFTER_DRAIN = false;
    const bf16* P; bf16* TMP; bf16* MG;
    __device__ __forceinline__ void operator()(const pg8::f32x4 (&acc)[2][2][4][2], const pg8::Unit& u, int wr, int wc, int fr, int fq) const {
        const int row0 = u.pm * 256 + wr * 64 + fr;
#pragma unroll
        for (int ai = 0; ai < 2; ++ai)
#pragma unroll
            for (int m = 0; m < 4; ++m) { const size_t row = (size_t)(row0 + ai * 128 + m * 16);
#pragma unroll
                for (int bj = 0; bj < 2; ++bj) { const int cc = u.pn * 256 + bj * 128 + wc * 32 + 8 * fq;
                    const u32x4 gw = *(const u32x4*)(P + row * NIN + (MODE == 0 ? PC_GR : PC_GA) + cc);
                    const f32x4 g0 = (f32x4){blo(gw.x), bhi(gw.x), blo(gw.y), bhi(gw.y)}, g1 = (f32x4){blo(gw.z), bhi(gw.z), blo(gw.w), bhi(gw.w)};
                    f32x4 o0 = g0 * acc[ai][bj][m][0], o1 = g1 * acc[ai][bj][m][1];
                    if (MODE == 1) { const u32x4 tw = *(const u32x4*)(TMP + row * D + cc);
                        o0 += (f32x4){blo(tw.x), bhi(tw.x), blo(tw.y), bhi(tw.y)}; o1 += (f32x4){blo(tw.z), bhi(tw.z), blo(tw.w), bhi(tw.w)}; }
                    u32x4 w; w.x = pg8::cvt_pk_bf16(o0[0], o0[1]); w.y = pg8::cvt_pk_bf16(o0[2], o0[3]); w.z = pg8::cvt_pk_bf16(o1[0], o1[1]); w.w = pg8::cvt_pk_bf16(o1[2], o1[3]);
                    *(u32x4*)((MODE == 0 ? TMP : MG) + row * D + cc) = w; }
                asm volatile("" ::: "memory"); }
    }
};
struct EpiRes {
    static constexpr bool PERM = false, AFTER_DRAIN = false;
    const float* base; float* out; const float* gate;
    __device__ __forceinline__ void operator()(const pg8::f32x4 (&acc)[2][2][4][2], const pg8::Unit& u, int wr, int wc, int fr, int fq) const {
        const int row0 = u.pm * 256 + wr * 64 + fr; const float* gt = gate + (u.pm >> 4) * MODW;
#pragma unroll
        for (int bj = 0; bj < 2; ++bj)
#pragma unroll
            for (int n = 0; n < 2; ++n) { const int cc = u.pn * 256 + bj * 128 + wc * 32 + 16 * n + 4 * fq; const f32x4 g = *(const f32x4*)(gt + cc);
#pragma unroll
                for (int ai = 0; ai < 2; ++ai) {
#pragma unroll
                    for (int m = 0; m < 4; ++m) { const size_t off = (size_t)(row0 + ai * 128 + m * 16) * D + cc;
                        const f32x4 bs = *(const f32x4*)(base + off); *(f32x4*)(out + off) = bs + g * acc[ai][bj][m][n]; }
                    asm volatile("" ::: "memory"); } }
    }
};
struct EpiUp {
    static constexpr bool PERM = true, AFTER_DRAIN = false;
    bf16* U;
    __device__ __forceinline__ void operator()(const pg8::f32x4 (&acc)[2][2][4][2], const pg8::Unit& u, int wr, int wc, int fr, int fq) const {
        const int row0 = u.pm * 256 + wr * 64 + fr;
#pragma unroll
        for (int bj = 0; bj < 2; ++bj) { const int col = u.pn * 256 + bj * 128 + wc * 32 + 8 * fq;
#pragma unroll
            for (int ai = 0; ai < 2; ++ai)
#pragma unroll
                for (int m = 0; m < 4; ++m) { f32x4 v0 = acc[ai][bj][m][0], v1 = acc[ai][bj][m][1];
#pragma unroll
                    for (int j = 0; j < 4; ++j) { const float a0 = fmaxf(v0[j], 0.f), a1 = fmaxf(v1[j], 0.f); v0[j] = a0 * a0; v1[j] = a1 * a1; }
                    u32x4 w; w.x = pg8::cvt_pk_bf16(v0[0], v0[1]); w.y = pg8::cvt_pk_bf16(v0[2], v0[3]); w.z = pg8::cvt_pk_bf16(v1[0], v1[1]); w.w = pg8::cvt_pk_bf16(v1[2], v1[3]);
                    *(u32x4*)(U + (size_t)(row0 + ai * 128 + m * 16) * FF + col) = w; } }
    }
};

__device__ __forceinline__ void transpose_item(const float* W, int ldw, int nsrc0, bf16* WT, int K, int rowdst0, int kb, int nb, LAS float* scr, int lane) {
    const int k0 = 64 * kb, n0 = 32 * nb, r8 = lane >> 3, cq = lane & 7;
    f32x4 v[8];
#pragma unroll
    for (int i = 0; i < 8; ++i) v[i] = *(const f32x4*)(W + (size_t)(k0 + i * 8 + r8) * ldw + nsrc0 + n0 + cq * 4);
#pragma unroll
    for (int i = 0; i < 8; ++i) { LAS float* d = scr + (i * 8 + r8) * 33 + cq * 4; d[0] = v[i].x; d[1] = v[i].y; d[2] = v[i].z; d[3] = v[i].w; }
    LDS_WAIT();
    const int c = lane & 7;
#pragma unroll
    for (int j = 0; j < 4; ++j) { const int n = (lane >> 3) + 8 * j; const LAS float* s = scr + (8 * c) * 33 + n;
        u32x4 o; o.x = pk2(s[0 * 33], s[1 * 33]); o.y = pk2(s[2 * 33], s[3 * 33]); o.z = pk2(s[4 * 33], s[5 * 33]); o.w = pk2(s[6 * 33], s[7 * 33]);
        *(u32x4*)(WT + (size_t)(rowdst0 + n0 + n) * K + k0 + 8 * c) = o; }
    LDS_WAIT();
}

__device__ __forceinline__ void norm_rows_bf16(const float* X, const float* gain, const float* mod, int sc_off, int sh_off, bf16* H, int gw, int NGW, int lane) {
    for (int m = gw; m < M; m += NGW) {
        const f32x4* xr = (const f32x4*)(X + (size_t)m * D) + lane; f32x4 v[8]; float ss = 0.f;
#pragma unroll
        for (int j = 0; j < 8; ++j) { v[j] = xr[64 * j]; ss += (v[j].x * v[j].x + v[j].y * v[j].y) + (v[j].z * v[j].z + v[j].w * v[j].w); }
        const float rstd = rsqrtf(wave_sum(ss) * (1.f / D) + 1e-6f);
        const float* sc = mod + (m >> 12) * MODW + sc_off; const float* sh = mod + (m >> 12) * MODW + sh_off;
        u32x2* o8 = (u32x2*)(H + (size_t)m * D) + lane;
#pragma unroll
        for (int j = 0; j < 8; ++j) { const int c = j * 256 + lane * 4; const f32x4 g = *(const f32x4*)(gain + c), s = *(const f32x4*)(sc + c), h = *(const f32x4*)(sh + c);
            const f32x4 o = v[j] * rstd * g * (s + 1.f) + h; u32x2 w; w.x = pk2(o.x, o.y); w.y = pk2(o.z, o.w); o8[64 * j] = w; }
    }
}

__device__ __forceinline__ void attn_unit(const bf16* P, const float* sinks, bf16* YATT, int u, LAS unsigned char* lds, int tid) {
    const int wave = tid >> 6, lane = tid & 63, fr = lane & 15, fq = lane >> 4;
    const int b = u >> 7, kvh = (u >> 6) & 1, qb = u & 63, q0 = qb * 64, key0 = q0 - 128;
    LAS bf16* Ks = (LAS bf16*)lds;
    LAS bf16* Vt = (LAS bf16*)(lds + 192 * 144);
    for (int i = tid; i < 1536; i += 512) {
        const int row = i >> 3, c = i & 7, tk = key0 + row; u32x4 kv = (u32x4){0u, 0u, 0u, 0u}, vv = kv;
        if (tk >= 0) { const bf16* src = P + (size_t)(b * T + tk) * NIN; kv = *(const u32x4*)(src + PC_AK + kvh * 64 + c * 8); vv = *(const u32x4*)(src + PC_AV + kvh * 64 + c * 8); }
        *(LAS u32x4*)(Ks + row * 72 + c * 8) = kv;
        LAS bf16* vd = Vt + (c * 8) * 200 + row;
        vd[0 * 200] = (bf16)(vv.x & 0xffffu); vd[1 * 200] = (bf16)(vv.x >> 16); vd[2 * 200] = (bf16)(vv.y & 0xffffu); vd[3 * 200] = (bf16)(vv.y >> 16);
        vd[4 * 200] = (bf16)(vv.z & 0xffffu); vd[5 * 200] = (bf16)(vv.z >> 16); vd[6 * 200] = (bf16)(vv.w & 0xffffu); vd[7 * 200] = (bf16)(vv.w >> 16);
    }
    __syncthreads();
    const int hq = kvh * 8 + wave; const float slope = exp2f(-0.5f * (float)(hq + 1)), sink = sinks[hq];
    bf16x8 bqn[2];
#pragma unroll
    for (int ks = 0; ks < 2; ++ks) bqn[ks] = *(const bf16x8*)(P + (size_t)(b * T + q0 + fr) * NIN + PC_Q + hq * 64 + ks * 32 + fq * 8);
#pragma unroll 1
    for (int nq = 0; nq < 4; ++nq) {
        bf16x8 bq[2];
#pragma unroll
        for (int ks = 0; ks < 2; ++ks) { bq[ks] = bqn[ks]; bqn[ks] = *(const bf16x8*)(P + (size_t)(b * T + q0 + (nq < 3 ? nq + 1 : nq) * 16 + fr) * NIN + PC_Q + hq * 64 + ks * 32 + fq * 8); }
        f32x4 st[9];
#pragma unroll
        for (int i = 0; i < 9; ++i) { f32x4 acc = (f32x4){0.f, 0.f, 0.f, 0.f};
#pragma unroll
            for (int ks = 0; ks < 2; ++ks) { const bf16x8 ak = *(const LAS bf16x8*)(Ks + ((nq + i) * 16 + fr) * 72 + ks * 32 + fq * 8); acc = __builtin_amdgcn_mfma_f32_16x16x32_bf16(ak, bq[ks], acc, 0, 0, 0); }
            st[i] = acc; }
        float mx = sink;
#pragma unroll
        for (int i = 0; i < 9; ++i)
#pragma unroll
            for (int j = 0; j < 4; ++j) { const int kr = (nq + i) * 16 + fq * 4 + j; const int dist = nq * 16 + fr + 128 - kr; const bool valid = (dist >= 0) && (dist < 128) && (key0 + kr >= 0);
                const float s = valid ? (st[i][j] * 0.125f - slope * (float)dist) : -1e30f; st[i][j] = s; mx = fmaxf(mx, s); }
        mx = fmaxf(mx, __shfl_xor(mx, 16)); mx = fmaxf(mx, __shfl_xor(mx, 32));
        float sum = 0.f;
#pragma unroll
        for (int i = 0; i < 9; ++i)
#pragma unroll
            for (int j = 0; j < 4; ++j) { const float p = __expf(st[i][j] - mx); st[i][j] = p; sum += p; }
        sum += __shfl_xor(sum, 16); sum += __shfl_xor(sum, 32); sum += __expf(sink - mx);
        const float inv = 1.0f / sum;
        bf16x8 pb[5];
#pragma unroll
        for (int kk = 0; kk < 5; ++kk) { u32x4 w; w.x = pk2(st[2 * kk][0] * inv, st[2 * kk][1] * inv); w.y = pk2(st[2 * kk][2] * inv, st[2 * kk][3] * inv);
            if (kk < 4) { w.z = pk2(st[2 * kk + 1][0] * inv, st[2 * kk + 1][1] * inv); w.w = pk2(st[2 * kk + 1][2] * inv, st[2 * kk + 1][3] * inv); } else { w.z = 0u; w.w = 0u; }
            pb[kk] = __builtin_bit_cast(bf16x8, w); }
#pragma unroll
        for (int mh = 0; mh < 4; ++mh) { f32x4 o = (f32x4){0.f, 0.f, 0.f, 0.f};
#pragma unroll
            for (int kk = 0; kk < 5; ++kk) { const int tA = nq + 2 * kk, tB = (kk < 4) ? tA + 1 : tA;
                const u32x2 lo = *(const LAS u32x2*)(Vt + (mh * 16 + fr) * 200 + tA * 16 + fq * 4), hi = *(const LAS u32x2*)(Vt + (mh * 16 + fr) * 200 + tB * 16 + fq * 4);
                const u32x4 av = (u32x4){lo.x, lo.y, hi.x, hi.y};
                o = __builtin_amdgcn_mfma_f32_16x16x32_bf16(__builtin_bit_cast(bf16x8, av), pb[kk], o, 0, 0, 0); }
            u32x2 w; w.x = pk2(o[0], o[1]); w.y = pk2(o[2], o[3]);
            *(u32x2*)(YATT + (size_t)(b * T + q0 + nq * 16 + fr) * C + hq * 64 + mh * 16 + fq * 4) = w; }
    }
    __syncthreads();
}

typedef __bf16 bf16x2_t __attribute__((ext_vector_type(2)));
typedef float f32x2_t __attribute__((ext_vector_type(2)));
__device__ __forceinline__ unsigned cvtpk(float lo, float hi) { const f32x2_t v = {lo, hi}; const bf16x2_t b = __builtin_convertvector(v, bf16x2_t); return __builtin_bit_cast(unsigned, b); }
__device__ __forceinline__ int swz(int row, int col) { return row * 128 + ((((col >> 3) ^ (row >> 1)) & 7) << 4) + (col & 7) * 2; }
__device__ __forceinline__ void st_T(LAS unsigned char* dst, int x, int y0, f32x4 v) { u32x2 w; w.x = cvtpk(v[0], v[1]); w.y = cvtpk(v[2], v[3]); *(LAS u32x2*)(dst + swz(x, y0)) = w; }
__device__ __forceinline__ void st_N(LAS unsigned char* dst, int x, int y0, f32x4 v) {
#pragma unroll
    for (int r = 0; r < 4; ++r) *(LAS bf16*)(dst + swz(y0 + r, x)) = (bf16)f2bf(v[r]);
}
__device__ __forceinline__ f32x4 ld4(const LAS unsigned char* src, int x, int y0) { const u32x2 w = *(const LAS u32x2*)(src + swz(x, y0)); return (f32x4){blo(w.x), bhi(w.x), blo(w.y), bhi(w.y)}; }
template <class Epi> __device__ __forceinline__ void nt64(const LAS unsigned char* X, const LAS unsigned char* Y, int wave, int lane, Epi epi) {
    asm volatile("" : "+v"(wave), "+v"(lane));
    const int p = wave >> 1, q0 = (wave & 1) * 2, lr = lane & 15, kg = lane >> 4;
    bf16x8 ya[2], xb[2][2];
    const int yrow = p * 16 + lr;
#pragma unroll
    for (int ks = 0; ks < 2; ++ks) ya[ks] = *(const LAS bf16x8*)(Y + yrow * 128 + ((((ks * 4 + kg) ^ (yrow >> 1)) & 7) << 4));
#pragma unroll
    for (int qi = 0; qi < 2; ++qi) { const int xrow = (q0 + qi) * 16 + lr;
#pragma unroll
        for (int ks = 0; ks < 2; ++ks) xb[qi][ks] = *(const LAS bf16x8*)(X + xrow * 128 + ((((ks * 4 + kg) ^ (xrow >> 1)) & 7) << 4)); }
#pragma unroll
    for (int qi = 0; qi < 2; ++qi) { f32x4 acc = (f32x4){0.f, 0.f, 0.f, 0.f};
#pragma unroll
        for (int ks = 0; ks < 2; ++ks) acc = __builtin_amdgcn_mfma_f32_16x16x32_bf16(ya[ks], xb[qi][ks], acc, 0, 0, 0);
        epi((q0 + qi) * 16 + lr, p * 16 + kg * 4, acc); }
}
template <class E1, class E2> __device__ __forceinline__ void nt64_2(const LAS unsigned char* X1, const LAS unsigned char* Y1, E1 e1, const LAS unsigned char* X2, const LAS unsigned char* Y2, E2 e2, int wave, int lane) {
    asm volatile("" : "+v"(wave), "+v"(lane));
    const int p = wave >> 1, q0 = (wave & 1) * 2, lr = lane & 15, kg = lane >> 4;
    bf16x8 ya1[2], xb1[2][2], ya2[2], xb2[2][2];
    const int yrow = p * 16 + lr;
#pragma unroll
    for (int ks = 0; ks < 2; ++ks) { const int o = yrow * 128 + ((((ks * 4 + kg) ^ (yrow >> 1)) & 7) << 4); ya1[ks] = *(const LAS bf16x8*)(Y1 + o); ya2[ks] = *(const LAS bf16x8*)(Y2 + o); }
#pragma unroll
    for (int qi = 0; qi < 2; ++qi) { const int xrow = (q0 + qi) * 16 + lr;
#pragma unroll
        for (int ks = 0; ks < 2; ++ks) { const int o = xrow * 128 + ((((ks * 4 + kg) ^ (xrow >> 1)) & 7) << 4); xb1[qi][ks] = *(const LAS bf16x8*)(X1 + o); xb2[qi][ks] = *(const LAS bf16x8*)(X2 + o); } }
#pragma unroll
    for (int qi = 0; qi < 2; ++qi) { f32x4 acc = (f32x4){0.f, 0.f, 0.f, 0.f};
#pragma unroll
        for (int ks = 0; ks < 2; ++ks) acc = __builtin_amdgcn_mfma_f32_16x16x32_bf16(ya1[ks], xb1[qi][ks], acc, 0, 0, 0);
        e1((q0 + qi) * 16 + lr, p * 16 + kg * 4, acc); }
#pragma unroll
    for (int qi = 0; qi < 2; ++qi) { f32x4 acc = (f32x4){0.f, 0.f, 0.f, 0.f};
#pragma unroll
        for (int ks = 0; ks < 2; ++ks) acc = __builtin_amdgcn_mfma_f32_16x16x32_bf16(ya2[ks], xb2[qi][ks], acc, 0, 0, 0);
        e2((q0 + qi) * 16 + lr, p * 16 + kg * 4, acc); }
}
#define CB(i) (lds + (i) * 8192)
constexpr int CK_PLV = 15 * 8192, CK_SEG = 15 * 8192 + 256;

__device__ __forceinline__ u32x4 shfl_up8(u32x4 v) { u32x4 o; o.x = __shfl_up(v.x, 8); o.y = __shfl_up(v.y, 8); o.z = __shfl_up(v.z, 8); o.w = __shfl_up(v.w, 8); return o; }
struct ChunkRaw { u32x4 rc, kc, vc, rp, kp, vp; f32x4 wl0, wl1, as0, as1; };
__device__ __forceinline__ ChunkRaw chunk_load_raw(const bf16* P, const float* WL, const float* AS, int q, int tid) {
    const int hh = q >> 6, c = q & 63, bb = hh >> 4, h = hh & 15;
    const int t = tid >> 3, c0 = (tid & 7) * 8, tt = c * 64 + t, col = h * 64 + c0; const size_t row = (size_t)bb * T + tt;
    const bf16* pr = P + row * NIN; ChunkRaw R;
    R.rc = *(const u32x4*)(pr + PC_R + col); R.kc = *(const u32x4*)(pr + PC_K + col); R.vc = *(const u32x4*)(pr + PC_V + col);
    R.rp = (u32x4){0u, 0u, 0u, 0u}; R.kp = R.rp; R.vp = R.rp;
    if (tt > 0 && (tid & 56) == 0) { R.rp = *(const u32x4*)(pr - NIN + PC_R + col); R.kp = *(const u32x4*)(pr - NIN + PC_K + col); R.vp = *(const u32x4*)(pr - NIN + PC_V + col); }
    R.wl0 = *(const f32x4*)(WL + row * C + col); R.wl1 = *(const f32x4*)(WL + row * C + col + 4);
    R.as0 = *(const f32x4*)(AS + row * C + col); R.as1 = *(const f32x4*)(AS + row * C + col + 4);
    return R;
}
__device__ __forceinline__ void chunk_pass_a_prep(const ChunkRaw RW, const float* mix, const float* k_k, const float* k_a, const float* r_k, float* BON, int q, LAS unsigned char* lds, int tid) {
    const int hh = q >> 6, h = hh & 15;
    {
        const int t = tid >> 3, c0 = (tid & 7) * 8, col = h * 64 + c0;
        const u32x4 rc = RW.rc, kc = RW.kc, vc = RW.vc; const bool first = (tid & 56) == 0;
        const u32x4 rs = shfl_up8(rc), ks_ = shfl_up8(kc), vs = shfl_up8(vc); const u32x4 rp = first ? RW.rp : rs, kp = first ? RW.kp : ks_, vp = first ? RW.vp : vs; const f32x4 wl0 = RW.wl0, wl1 = RW.wl1, as0 = RW.as0, as1 = RW.as1;
        float r[8], k[8], v[8], rq[8], kq[8], vq[8], kk[8], wl[8], as[8];
        r[0] = blo(rc.x); r[1] = bhi(rc.x); r[2] = blo(rc.y); r[3] = bhi(rc.y); r[4] = blo(rc.z); r[5] = bhi(rc.z); r[6] = blo(rc.w); r[7] = bhi(rc.w);
        k[0] = blo(kc.x); k[1] = bhi(kc.x); k[2] = blo(kc.y); k[3] = bhi(kc.y); k[4] = blo(kc.z); k[5] = bhi(kc.z); k[6] = blo(kc.w); k[7] = bhi(kc.w);
        v[0] = blo(vc.x); v[1] = bhi(vc.x); v[2] = blo(vc.y); v[3] = bhi(vc.y); v[4] = blo(vc.z); v[5] = bhi(vc.z); v[6] = blo(vc.w); v[7] = bhi(vc.w);
        rq[0] = blo(rp.x); rq[1] = bhi(rp.x); rq[2] = blo(rp.y); rq[3] = bhi(rp.y); rq[4] = blo(rp.z); rq[5] = bhi(rp.z); rq[6] = blo(rp.w); rq[7] = bhi(rp.w);
        kq[0] = blo(kp.x); kq[1] = bhi(kp.x); kq[2] = blo(kp.y); kq[3] = bhi(kp.y); kq[4] = blo(kp.z); kq[5] = bhi(kp.z); kq[6] = blo(kp.w); kq[7] = bhi(kp.w);
        vq[0] = blo(vp.x); vq[1] = bhi(vp.x); vq[2] = blo(vp.y); vq[3] = bhi(vp.y); vq[4] = blo(vp.z); vq[5] = bhi(vp.z); vq[6] = blo(vp.w); vq[7] = bhi(vp.w);
#pragma unroll
        for (int e = 0; e < 4; ++e) { wl[e] = wl0[e]; wl[4 + e] = wl1[e]; as[e] = as0[e]; as[4 + e] = as1[e]; }
        float ss = 0.f;
#pragma unroll
        for (int e = 0; e < 8; ++e) { r[e] = r[e] + (rq[e] - r[e]) * mix[PC_R + col + e]; k[e] = k[e] + (kq[e] - k[e]) * mix[PC_K + col + e]; v[e] = v[e] + (vq[e] - v[e]) * mix[PC_V + col + e];
            kk[e] = k[e] * k_k[col + e]; ss += kk[e] * kk[e]; }
        ss += __shfl_xor(ss, 1); ss += __shfl_xor(ss, 2); ss += __shfl_xor(ss, 4);
        const float inv = 1.0f / fmaxf(sqrtf(ss), 1e-12f);
        LAS float* clb = (LAS float*)CB(13); LAS float* seg = (LAS float*)(lds + CK_SEG);
        *(LAS f32x4*)(clb + t * 64 + c0) = wl0; *(LAS f32x4*)(clb + t * 64 + c0 + 4) = wl1;
        __syncthreads();
        { const int j = tid & 63, sg = tid >> 6; float run = 0.f;
#pragma unroll
          for (int e = 0; e < 8; ++e) { run += clb[(sg * 8 + e) * 64 + j]; clb[(sg * 8 + e) * 64 + j] = run; }
          seg[sg * 64 + j] = run; }
        __syncthreads();
        float off[8], tot[8];
#pragma unroll
        for (int e = 0; e < 8; ++e) { off[e] = 0.f; tot[e] = 0.f; }
#pragma unroll
        for (int s = 0; s < 8; ++s) { const f32x4 s0 = *(const LAS f32x4*)(seg + s * 64 + c0), s1 = *(const LAS f32x4*)(seg + s * 64 + c0 + 4); const float m = (s < (t >> 3)) ? 1.f : 0.f;
#pragma unroll
            for (int e = 0; e < 4; ++e) { tot[e] += s0[e]; tot[4 + e] += s1[e]; off[e] += m * s0[e]; off[4 + e] += m * s1[e]; } }
        const f32x4 ci0 = *(const LAS f32x4*)(clb + t * 64 + c0), ci1 = *(const LAS f32x4*)(clb + t * 64 + c0 + 4);
        float oA[8], oB[8], oK[8], oR[8], oBh[8], oKh[8]; float sbon = 0.f;
#pragma unroll
        for (int e = 0; e < 8; ++e) { const float ci = (e < 4 ? ci0[e & 3] : ci1[e & 3]) + off[e]; const float er = __expf(ci), ea = __expf(ci - wl[e]), pt = __expf(tot[e]), eb = __builtin_amdgcn_rcpf(er), eh = pt * eb;
            const float kn = kk[e] * inv, bv = kn * as[e], km = k[e] * (1.f + (as[e] - 1.f) * k_a[col + e]);
            oA[e] = -kn * ea; oB[e] = bv * eb; oK[e] = km * eb; oR[e] = r[e] * er; oBh[e] = bv * eh; oKh[e] = km * eh; sbon += r[e] * km * r_k[col + e];
            if (t == 0) ((LAS float*)(lds + CK_PLV))[c0 + e] = pt; }
        sbon += __shfl_xor(sbon, 1); sbon += __shfl_xor(sbon, 2); sbon += __shfl_xor(sbon, 4);
        if ((tid & 7) == 0) { const int c_ = q & 63, bb_ = hh >> 4; BON[((size_t)bb_ * T + c_ * 64 + t) * 16 + h] = sbon; }
        u32x4 w;
        w.x = pk2(oA[0], oA[1]); w.y = pk2(oA[2], oA[3]); w.z = pk2(oA[4], oA[5]); w.w = pk2(oA[6], oA[7]); *(LAS u32x4*)(CB(0) + swz(t, c0)) = w;
        w.x = pk2(oB[0], oB[1]); w.y = pk2(oB[2], oB[3]); w.z = pk2(oB[4], oB[5]); w.w = pk2(oB[6], oB[7]); *(LAS u32x4*)(CB(2) + swz(t, c0)) = w;
        w.x = pk2(oK[0], oK[1]); w.y = pk2(oK[2], oK[3]); w.z = pk2(oK[4], oK[5]); w.w = pk2(oK[6], oK[7]); *(LAS u32x4*)(CB(3) + swz(t, c0)) = w;
        w.x = pk2(oR[0], oR[1]); w.y = pk2(oR[2], oR[3]); w.z = pk2(oR[4], oR[5]); w.w = pk2(oR[6], oR[7]); *(LAS u32x4*)(CB(4) + swz(t, c0)) = w;
#pragma unroll
        for (int e = 0; e < 8; ++e) { *(LAS bf16*)(CB(1) + swz(c0 + e, t)) = (bf16)f2bf(oA[e]); *(LAS bf16*)(CB(5) + swz(c0 + e, t)) = (bf16)f2bf(oBh[e]);
            *(LAS bf16*)(CB(6) + swz(c0 + e, t)) = (bf16)f2bf(oKh[e]); *(LAS bf16*)(CB(7) + swz(c0 + e, t)) = (bf16)f2bf(v[e]); }
    }
}
__device__ __forceinline__ void chunk_pass_a_mm(bf16* MC, bf16* QC, float* NC, float* YI, int q, LAS unsigned char* lds, int tid) {
    const int wave = tid >> 6, lane = tid & 63;
    __syncthreads();
    nt64_2(CB(2), CB(0), [=](int x, int y0, f32x4 v) {
#pragma unroll
        for (int r = 0; r < 4; ++r) v[r] = (x < y0 + r) ? v[r] : 0.f;
        st_T(CB(8), x, y0, v); st_N(CB(9), x, y0, v);
#pragma unroll
        for (int r = 0; r < 4; ++r) v[r] += (x == y0 + r) ? 1.f : 0.f;
        st_T(CB(13), x, y0, v); },
           CB(3), CB(0), [=](int x, int y0, f32x4 v) {
#pragma unroll
        for (int r = 0; r < 4; ++r) v[r] = (x < y0 + r) ? v[r] : 0.f;
        st_T(CB(10), x, y0, v); }, wave, lane);
    nt64_2(CB(4), CB(2), [=](int x, int y0, f32x4 v) {
#pragma unroll
        for (int r = 0; r < 4; ++r) v[r] = (y0 + r <= x) ? v[r] : 0.f;
        st_T(CB(11), x, y0, v); },
           CB(4), CB(3), [=](int x, int y0, f32x4 v) {
#pragma unroll
        for (int r = 0; r < 4; ++r) v[r] = (y0 + r <= x) ? v[r] : 0.f;
        st_T(CB(12), x, y0, v); }, wave, lane);
    __syncthreads();
    nt64(CB(8), CB(9), wave, lane, [=](int x, int y0, f32x4 v) { st_T(CB(2), x, y0, v); st_N(CB(3), x, y0, v); });
    __syncthreads();
    nt64_2(CB(13), CB(3), [=](int x, int y0, f32x4 v) { v += ld4(CB(13), x, y0); st_T(CB(14), x, y0, v); },
           CB(2), CB(3), [=](int x, int y0, f32x4 v) { st_T(CB(8), x, y0, v); st_N(CB(9), x, y0, v); }, wave, lane);
    __syncthreads();
    nt64_2(CB(14), CB(9), [=](int x, int y0, f32x4 v) { v += ld4(CB(14), x, y0); st_T(CB(13), x, y0, v); },
           CB(8), CB(9), [=](int x, int y0, f32x4 v) { st_T(CB(2), x, y0, v); st_N(CB(3), x, y0, v); }, wave, lane);
    __syncthreads();
    nt64_2(CB(13), CB(3), [=](int x, int y0, f32x4 v) { v += ld4(CB(13), x, y0); st_T(CB(14), x, y0, v); },
           CB(2), CB(3), [=](int x, int y0, f32x4 v) { st_T(CB(8), x, y0, v); st_N(CB(9), x, y0, v); }, wave, lane);
    __syncthreads();
    nt64_2(CB(14), CB(9), [=](int x, int y0, f32x4 v) { v += ld4(CB(14), x, y0); st_T(CB(13), x, y0, v); },
           CB(9), CB(8), [=](int x, int y0, f32x4 v) { st_T(CB(3), x, y0, v); }, wave, lane);
    __syncthreads();
    nt64(CB(13), CB(3), wave, lane, [=](int x, int y0, f32x4 v) { v += ld4(CB(13), x, y0); st_T(CB(14), x, y0, v); });
    __syncthreads();
    nt64_2(CB(5), CB(14), [=](int x, int y0, f32x4 v) { st_T(CB(2), x, y0, v); },
           CB(11), CB(14), [=](int x, int y0, f32x4 v) { st_T(CB(8), x, y0, v); }, wave, lane);
    __syncthreads();
    { bf16* mc = MC + (size_t)q * 4096; bf16* qc = QC + (size_t)q * 4096; const LAS float* plv = (const LAS float*)(lds + CK_PLV);
      nt64_2(CB(2), CB(1), [=](int x, int y0, f32x4 v) {
#pragma unroll
          for (int r = 0; r < 4; ++r) v[r] += (x == y0 + r) ? plv[x] : 0.f;
          u32x2 w; w.x = cvtpk(v[0], v[1]); w.y = cvtpk(v[2], v[3]); *(u32x2*)(mc + x * 64 + y0) = w; },
             CB(2), CB(10), [=](int x, int y0, f32x4 v) { v += ld4(CB(6), x, y0); st_T(CB(9), x, y0, v); }, wave, lane);
      nt64_2(CB(8), CB(1), [=](int x, int y0, f32x4 v) { v += ld4(CB(4), x, y0);
          u32x2 w; w.x = cvtpk(v[0], v[1]); w.y = cvtpk(v[2], v[3]); *(u32x2*)(qc + x * 64 + y0) = w; },
             CB(8), CB(10), [=](int x, int y0, f32x4 v) { v += ld4(CB(12), x, y0); st_T(CB(3), x, y0, v); }, wave, lane); }
    __syncthreads();
    { float* nc = NC + (size_t)q * 4096; bf16* yi = (bf16*)YI + (size_t)q * 4096;
      nt64_2(CB(7), CB(9), [=](int x, int y0, f32x4 v) { *(f32x4*)(nc + x * 64 + y0) = v; },
             CB(3), CB(7), [=](int x, int y0, f32x4 v) { u32x2 w; w.x = cvtpk(v[0], v[1]); w.y = cvtpk(v[2], v[3]); *(u32x2*)(yi + x * 64 + y0) = w; }, wave, lane); }
    __syncthreads();
}

__device__ __forceinline__ void chunk_pass_b(const bf16* MC, const float* NC, bf16* SC, int hh, int wave, int lane, volatile LAS int* prog) {
    const int i0 = wave * 16, lr = lane & 15, kg = lane >> 4;
    f32x4 st[4];
#pragma unroll
    for (int jt = 0; jt < 4; ++jt) st[jt] = (f32x4){0.f, 0.f, 0.f, 0.f};
    u32x2 mlo[3][4][2], mhi[3][4][2]; f32x4 nc[3][4];
#define PB_LOAD(S, CH) do { const int ch_ = (CH) < 64 ? (CH) : 63; const bf16* mc_ = MC + ((size_t)hh * 64 + ch_) * 4096; const float* nn_ = NC + ((size_t)hh * 64 + ch_) * 4096; \
        _Pragma("unroll") for (int jt = 0; jt < 4; ++jt) { nc[S][jt] = *(const f32x4*)(nn_ + (i0 + lr) * 64 + jt * 16 + kg * 4); \
            _Pragma("unroll") for (int ks = 0; ks < 2; ++ks) { mlo[S][jt][ks] = *(const u32x2*)(mc_ + (jt * 16 + lr) * 64 + (2 * ks) * 16 + kg * 4); mhi[S][jt][ks] = *(const u32x2*)(mc_ + (jt * 16 + lr) * 64 + (2 * ks + 1) * 16 + kg * 4); } } } while (0)
    PB_LOAD(0, 0); PB_LOAD(1, 1); PB_LOAD(2, 2);
    for (int c3 = 0; c3 < 66; c3 += 3) {
#pragma unroll
        for (int S = 0; S < 3; ++S) { const int c = c3 + S;
            if (lane == 0) *prog = c;
            u32x2 sp[4];
#pragma unroll
            for (int jt = 0; jt < 4; ++jt) { sp[jt].x = cvtpk(st[jt][0], st[jt][1]); sp[jt].y = cvtpk(st[jt][2], st[jt][3]); }
            if (c < 64) {
#pragma unroll
                for (int jt = 0; jt < 4; ++jt) *(u32x2*)(SC + ((size_t)hh * 64 + c) * 4096 + (i0 + lr) * 64 + jt * 16 + kg * 4) = sp[jt];
            }
            bf16x8 bfr[2];
#pragma unroll
            for (int ks = 0; ks < 2; ++ks) { const u32x4 w = (u32x4){sp[2 * ks].x, sp[2 * ks].y, sp[2 * ks + 1].x, sp[2 * ks + 1].y}; bfr[ks] = __builtin_bit_cast(bf16x8, w); }
#pragma unroll
            for (int jt = 0; jt < 4; ++jt) { f32x4 acc = nc[S][jt];
#pragma unroll
                for (int ks = 0; ks < 2; ++ks) { const u32x4 aw = (u32x4){mlo[S][jt][ks].x, mlo[S][jt][ks].y, mhi[S][jt][ks].x, mhi[S][jt][ks].y};
                    acc = __builtin_amdgcn_mfma_f32_16x16x32_bf16(__builtin_bit_cast(bf16x8, aw), bfr[ks], acc, 0, 0, 0); }
                st[jt] = acc; }
            PB_LOAD(S, c + 3);
        }
    }
#undef PB_LOAD
}
__device__ __forceinline__ void chunk_pass_b_touch(const bf16* MC, const float* NC, int hh, int slice, int hw, int lane, volatile LAS int* prog) {
    for (int c = 1 + hw; c < 64; c += 7) {
        while (*prog + 12 < c) __builtin_amdgcn_s_sleep(4);
        const u32x4* m = (const u32x4*)(MC + ((size_t)hh * 64 + c) * 4096) + lane; const u32x4* n = (const u32x4*)(NC + ((size_t)hh * 64 + c) * 4096 + slice * 16 * 64) + lane;
#pragma unroll
        for (int k = 0; k < 8; ++k) { const u32x4 v = m[64 * k]; asm volatile("" :: "v"(v)); }
#pragma unroll
        for (int k = 0; k < 4; ++k) { const u32x4 v = n[64 * k]; asm volatile("" :: "v"(v)); }
    }
}
__device__ __forceinline__ void chunk_pass_c(const bf16* QC, const bf16* SC, const float* YI, float* YRAW, int q, int wave, int lane) {
    const int hh = q >> 6, c = q & 63, bb = hh >> 4, h = hh & 15;
    const int p = wave >> 1, q0 = (wave & 1) * 2, lr = lane & 15, kg = lane >> 4;
    const bf16* qc = QC + (size_t)q * 4096; const bf16* sc = SC + (size_t)q * 4096; const float* yi = YI + (size_t)q * 4096;
    bf16x8 ya[2], xb[2][2];
#pragma unroll
    for (int ks = 0; ks < 2; ++ks) ya[ks] = *(const bf16x8*)(sc + (p * 16 + lr) * 64 + ks * 32 + kg * 8);
#pragma unroll
    for (int qi = 0; qi < 2; ++qi)
#pragma unroll
        for (int ks = 0; ks < 2; ++ks) xb[qi][ks] = *(const bf16x8*)(qc + ((q0 + qi) * 16 + lr) * 64 + ks * 32 + kg * 8);
#pragma unroll
    for (int qi = 0; qi < 2; ++qi) { const int t = (q0 + qi) * 16 + lr, i = p * 16 + kg * 4;
        f32x4 acc = *(const f32x4*)(yi + t * 64 + i);
#pragma unroll
        for (int ks = 0; ks < 2; ++ks) acc = __builtin_amdgcn_mfma_f32_16x16x32_bf16(ya[ks], xb[qi][ks], acc, 0, 0, 0);
        *(f32x4*)(YRAW + ((size_t)bb * T + c * 64 + t) * C + h * 64 + i) = acc; }
}

__device__ __forceinline__ void chunk_pass_c_fin(const bf16* QC, const bf16* SC, const float* YI, const bf16* P, const float* BON, const bf16* GG,
                                                 const float* mix, const float* ln_w, const float* ln_b, bf16* YR,
                                                 int q, int it, LAS unsigned char* lds, int tid, int wave, int lane) {
    const int hh = q >> 6, c = q & 63, bb = hh >> 4, h = hh & 15;
    const int t = tid >> 3, c0 = (tid & 7) * 8, tt = c * 64 + t, col = h * 64 + c0; const size_t row = (size_t)bb * T + tt;
    const bf16* pr = P + row * NIN;
    const u32x4 vc = *(const u32x4*)(pr + PC_V + col);
    u32x4 vp = (u32x4){0u, 0u, 0u, 0u};
    const bool first = (tid & 56) == 0;
    if (tt > 0 && first) vp = *(const u32x4*)(pr - NIN + PC_V + col);
    const float sb = BON[row * 16 + h];
    const u32x4 gw4 = *(const u32x4*)(GG + row * C + col);
    LAS float* yb = (LAS float*)lds + (it & 1) * (64 * 68);
    {
        const int p = wave >> 1, q0 = (wave & 1) * 2, lr = lane & 15, kg = lane >> 4;
        const bf16* qc = QC + (size_t)q * 4096; const bf16* sc = SC + (size_t)q * 4096; const bf16* yi = (const bf16*)YI + (size_t)q * 4096;
        bf16x8 ya[2], xb[2][2];
#pragma unroll
        for (int ks = 0; ks < 2; ++ks) ya[ks] = *(const bf16x8*)(sc + (p * 16 + lr) * 64 + ks * 32 + kg * 8);
#pragma unroll
        for (int qi = 0; qi < 2; ++qi)
#pragma unroll
            for (int ks = 0; ks < 2; ++ks) xb[qi][ks] = *(const bf16x8*)(qc + ((q0 + qi) * 16 + lr) * 64 + ks * 32 + kg * 8);
#pragma unroll
        for (int qi = 0; qi < 2; ++qi) { const int t2 = (q0 + qi) * 16 + lr, i2 = p * 16 + kg * 4;
            const u32x2 yw = *(const u32x2*)(yi + t2 * 64 + i2); f32x4 acc = (f32x4){blo(yw.x), bhi(yw.x), blo(yw.y), bhi(yw.y)};
#pragma unroll
            for (int ks = 0; ks < 2; ++ks) acc = __builtin_amdgcn_mfma_f32_16x16x32_bf16(ya[ks], xb[qi][ks], acc, 0, 0, 0);
            *(LAS f32x4*)(yb + t2 * 68 + i2) = acc; }
    }
    __syncthreads();
    { const u32x4 vs = shfl_up8(vc); if (!first) vp = vs; }
    const f32x4 y0 = *(const LAS f32x4*)(yb + t * 68 + c0), y1 = *(const LAS f32x4*)(yb + t * 68 + c0 + 4);
    float v[8], vq[8], g[8], y[8];
    v[0] = blo(vc.x); v[1] = bhi(vc.x); v[2] = blo(vc.y); v[3] = bhi(vc.y); v[4] = blo(vc.z); v[5] = bhi(vc.z); v[6] = blo(vc.w); v[7] = bhi(vc.w);
    vq[0] = blo(vp.x); vq[1] = bhi(vp.x); vq[2] = blo(vp.y); vq[3] = bhi(vp.y); vq[4] = blo(vp.z); vq[5] = bhi(vp.z); vq[6] = blo(vp.w); vq[7] = bhi(vp.w);
    g[0] = blo(gw4.x); g[1] = bhi(gw4.x); g[2] = blo(gw4.y); g[3] = bhi(gw4.y); g[4] = blo(gw4.z); g[5] = bhi(gw4.z); g[6] = blo(gw4.w); g[7] = bhi(gw4.w);
#pragma unroll
    for (int e = 0; e < 4; ++e) { y[e] = y0[e]; y[4 + e] = y1[e]; }
    float sy = 0.f;
#pragma unroll
    for (int e = 0; e < 8; ++e) { v[e] = v[e] + (vq[e] - v[e]) * mix[PC_V + col + e]; sy += y[e]; }
    sy += __shfl_xor(sy, 1); sy += __shfl_xor(sy, 2); sy += __shfl_xor(sy, 4);
    const float mu = sy * (1.f / 64.f); float sq = 0.f;
#pragma unroll
    for (int e = 0; e < 8; ++e) { const float d = y[e] - mu; sq += d * d; }
    sq += __shfl_xor(sq, 1); sq += __shfl_xor(sq, 2); sq += __shfl_xor(sq, 4);
    const float rstd = rsqrtf(sq * (1.f / 64.f) + 64e-5f);
    float o[8];
#pragma unroll
    for (int e = 0; e < 8; ++e) o[e] = ((y[e] - mu) * rstd * ln_w[col + e] + ln_b[col + e] + sb * v[e]) * g[e];
    u32x4 w; w.x = pk2(o[0], o[1]); w.y = pk2(o[2], o[3]); w.z = pk2(o[4], o[5]); w.w = pk2(o[6], o[7]);
    *(u32x4*)(YR + row * C + col) = w;
}

#define XB_TMO      128
#define XB_XCNT(j)  (256  + 64 * (j))
#define XB_XSUB(j)  (1280 + 64 * (j))
#define XB_XGEN(j)  (2304 + 64 * (j))
#define XB_TOP      3328
#define XB_TOPGEN   3392
#define XCD_BAR_WORDS 3456
#define XB_SPIN_CAP (1u << 18)

__device__ __forceinline__ unsigned xb_ld(unsigned* p)              { return __hip_atomic_load(p, __ATOMIC_RELAXED, __HIP_MEMORY_SCOPE_AGENT); }
__device__ __forceinline__ unsigned xb_add(unsigned* p, unsigned v) { return __hip_atomic_fetch_add(p, v, __ATOMIC_RELAXED, __HIP_MEMORY_SCOPE_AGENT); }
__device__ __forceinline__ unsigned xb_xcc_id() { return (unsigned)__builtin_amdgcn_s_getreg((3 << 11) | 20) & 0xFu; }
#define XB_SPIN(cond, bar) do { unsigned _sp = 0; while (cond) {   \
    if ((++_sp & 255u) == 0u) { if (xb_ld(&(bar)[XB_TMO])) break; if (_sp > XB_SPIN_CAP) { atomicAdd(&(bar)[XB_TMO], 1u); break; } } } } while (0)

struct XcdBarrier {
    unsigned* bar; unsigned x;
    volatile LAS unsigned* st;
};

__device__ __forceinline__ XcdBarrier xcd_barrier_post(unsigned* bar, volatile LAS unsigned* st) {
    XcdBarrier b; b.bar = bar; b.x = xb_xcc_id(); b.st = st;
    if (threadIdx.x == 0) (void)xb_add(&bar[XB_XCNT(b.x)], 1u);
    return b;
}
__device__ __forceinline__ void xcd_barrier_complete(unsigned* bar, unsigned x, unsigned& nloc, unsigned& nx) {
    const unsigned G = gridDim.x * gridDim.y * gridDim.z;
    unsigned sum, cnt, mine, sp = 0u;
    for (;;) {
        sum = 0u; cnt = 0u; mine = 0u;
#pragma unroll
        for (unsigned j = 0; j < 16; ++j) { const unsigned c = xb_ld(&bar[XB_XCNT(j)]); sum += c; cnt += (c > 0u) ? 1u : 0u; mine = (j == x) ? c : mine; }
        if (sum == G) break;
        __builtin_amdgcn_s_sleep(1);
        if ((++sp & 255u) == 0u) { if (xb_ld(&bar[XB_TMO])) break; if (sp > XB_SPIN_CAP) { atomicAdd(&bar[XB_TMO], 1u); break; } }
    }
    nloc = mine > 0u ? mine : 1u; nx = cnt > 0u ? cnt : 1u;
}

__device__ __forceinline__ void xcd_barrier(const XcdBarrier& b, bool leader) {
    asm volatile("s_waitcnt vmcnt(0)" ::: "memory");
    __syncthreads();
    if (leader) {
        unsigned* bar = b.bar;
        __builtin_amdgcn_s_waitcnt(0);
        unsigned nloc = b.st[0], nx = b.st[1];
        if (nloc == 0u) { xcd_barrier_complete(bar, b.x, nloc, nx); b.st[0] = nloc; b.st[1] = nx; }
        const unsigned old = xb_add(&bar[XB_XSUB(b.x)], 1u);
        const unsigned gen = old / nloc;
        if (old + 1u == (gen + 1u) * nloc) {
            __builtin_amdgcn_fence(__ATOMIC_RELEASE, "agent");
            asm volatile("s_waitcnt vmcnt(0)" ::: "memory");
            const unsigned og = xb_add(&bar[XB_TOP], 1u);
            const unsigned tg = og / nx;
            if (og + 1u == (tg + 1u) * nx) xb_add(&bar[XB_TOPGEN], 1u);
            else XB_SPIN(xb_ld(&bar[XB_TOPGEN]) == tg, bar);
            __builtin_amdgcn_fence(__ATOMIC_ACQUIRE, "agent");
            xb_add(&bar[XB_XGEN(b.x)], 1u);
            asm volatile("s_waitcnt vmcnt(0)" ::: "memory");
        } else {
            XB_SPIN(xb_ld(&bar[XB_XGEN(b.x)]) == gen, bar);
            __builtin_amdgcn_fence(__ATOMIC_ACQUIRE, "agent");
            asm volatile("s_waitcnt vmcnt(0)" ::: "memory");
        }
    }
    __syncthreads();
}

template <int MODE> struct EpiResNorm {
    static constexpr bool PERM = false, AFTER_DRAIN = true;
    const float* base; float* x1out; const float* gate; float* rowss; const float* gain; const float* mod; bf16* Hout; float* fout; unsigned* bar;
    __device__ __forceinline__ void fused(pg8::f32x4 (&acc)[2][2][4][2], const pg8::Unit& u, int wr, int wc, int fr, int fq, LAS unsigned char* lds, int wid, int lane) const {
        const int row0 = u.pm * 256 + wr * 64 + fr, bt = u.pm >> 4, c0 = u.pn * 256 + wc * 32 + 4 * fq; const float* gt = gate + bt * MODW;
#pragma unroll
        for (int bj = 0; bj < 2; ++bj)
#pragma unroll
            for (int n = 0; n < 2; ++n) { const int cc = c0 + bj * 128 + 16 * n; const f32x4 g = *(const f32x4*)(gt + cc);
#pragma unroll
                for (int ai = 0; ai < 2; ++ai) {
#pragma unroll
                    for (int m = 0; m < 4; ++m) { const size_t off = (size_t)(row0 + ai * 128 + m * 16) * D + cc;
                        const f32x4 bs = *(const f32x4*)(base + off); const f32x4 a = bs + g * acc[ai][bj][m][n]; acc[ai][bj][m][n] = a; asm volatile("" : "+v"(acc[ai][bj][m][n]));
                        if (MODE == 0) *(f32x4*)(x1out + off) = a;
                        if (m & 1) asm volatile("" ::: "memory"); } } }
#pragma unroll
        for (int ai = 0; ai < 2; ++ai)
#pragma unroll
            for (int m = 0; m < 4; ++m) { float s = 0.f;
#pragma unroll
                for (int bj = 0; bj < 2; ++bj)
#pragma unroll
                    for (int n = 0; n < 2; ++n) { const f32x4 a = acc[ai][bj][m][n]; s += (a[0] * a[0] + a[1] * a[1]) + (a[2] * a[2] + a[3] * a[3]); }
                s += __shfl_xor(s, 16); s += __shfl_xor(s, 32);
                if (fq == 0) (void)__hip_atomic_fetch_add(rowss + row0 + ai * 128 + m * 16, s, __ATOMIC_RELAXED, __HIP_MEMORY_SCOPE_AGENT); }
        { XcdBarrier xb; xb.bar = bar; xb.x = xb_xcc_id(); xb.st = (volatile LAS unsigned*)(lds + 131072); xcd_barrier(xb, wid == 0 && lane == 0); }
        int row0b = row0, c0b = c0; asm volatile("" : "+v"(row0b), "+v"(c0b));
#pragma unroll
        for (int ai = 0; ai < 2; ++ai)
#pragma unroll
            for (int m = 0; m < 4; ++m) { const int row = row0b + ai * 128 + m * 16;
                const float ss = __hip_atomic_load(rowss + row, __ATOMIC_RELAXED, __HIP_MEMORY_SCOPE_AGENT); const float rstd = rsqrtf(ss * (1.f / D) + 1e-6f);
#pragma unroll
                for (int bj = 0; bj < 2; ++bj)
#pragma unroll
                    for (int n = 0; n < 2; ++n) { const int cc = c0b + bj * 128 + 16 * n; const f32x4 gn = *(const f32x4*)(gain + cc); f32x4 o = acc[ai][bj][m][n] * rstd * gn;
                        if (MODE == 0) { const f32x4 sc = *(const f32x4*)(mod + bt * MODW + 4 * D + cc), sh = *(const f32x4*)(mod + bt * MODW + 3 * D + cc); o = o * (sc + 1.f) + sh;
                            u32x2 w; w.x = pk2(o[0], o[1]); w.y = pk2(o[2], o[3]); *(u32x2*)(Hout + (size_t)row * D + cc) = w; }
                        else *(f32x4*)(fout + (size_t)row * D + cc) = o; }
                asm volatile("" ::: "memory"); }
    }
};

__global__ void __launch_bounds__(512, 2) fwd(Args a) {
    extern __shared__ __attribute__((aligned(16))) unsigned char lds_raw[];
    cg::grid_group grid = cg::this_grid();
    LAS unsigned char* lds = (LAS unsigned char*)lds_raw;
    typedef const __attribute__((address_space(4))) Args* KArgs;
    const int G = gridDim.x, bx = blockIdx.x, NGW = G * 8, NT = G * 512;
    { volatile LAS unsigned* stz = (volatile LAS unsigned*)(lds + 131072); if (threadIdx.x < 64) stz[threadIdx.x] = 0u;
      if ((threadIdx.x & 63) == 0) ((volatile LAS int*)(lds + TID_TAB_OFF))[(unsigned)__builtin_amdgcn_s_getreg(0x2804) & 63u] = (int)(threadIdx.x >> 6); }
    __syncthreads();
    if (__builtin_expect(((KArgs)__builtin_amdgcn_kernarg_segment_ptr())->ph_hi == 0x7fffffff, 0)) grid.sync();
    (void)xcd_barrier_post((unsigned*)(((KArgs)__builtin_amdgcn_kernarg_segment_ptr())->ws), (volatile LAS unsigned*)(lds + 131072));
    const KArgs kp0 = (KArgs)__builtin_amdgcn_kernarg_segment_ptr();
#define PHASE_PTRS() KArgs kp; asm volatile("" : "=s"(kp) : "0"(kp0)); unsigned char* ws = kp->ws; (void)ws; \
    const int lane = get_lane(), wave = get_wave(lds), tid = wave * 64 + lane, gw = bx * 8 + wave, gt = bx * 512 + tid; (void)lane; (void)gw; (void)gt
#define MOD ((float*)(ws + WS_MOD))
#define BIASP ((float*)(ws + WS_BIASP))
#define WLORA ((bf16*)(ws + WS_WLORA))
#define WIN ((bf16*)(ws + WS_WIN))
#define WBR ((bf16*)(ws + WS_WBR))
#define WBA ((bf16*)(ws + WS_WBA))
#define WOUT ((bf16*)(ws + WS_WOUT))
#define WUP ((bf16*)((unsigned char*)AOUT + 32 * MiB))
#define TMPB ((bf16*)(ws + 8 * MiB))
#define WDOWN ((bf16*)(ws + WS_WDOWN))
#define YATT ((bf16*)(ws + WS_WL + 16 * MiB))
#define YR ((bf16*)(ws + WS_YR))
#define H ((bf16*)(ws + WS_H))
#define YRAW ((float*)(ws + WS_H))
#define MG ((bf16*)(ws + WS_H))
#define P ((bf16*)(ws + WS_P))
#define U ((bf16*)(ws + WS_P))
#define AL ((bf16*)(ws + WS_AL))
#define WL ((float*)(ws + WS_WL))
#define AS ((float*)(ws + WS_AS))
#define X1 ((float*)(ws + WS_WL))
#define GG ((bf16*)(ws + WS_GG))
#define MCB ((bf16*)(ws + 8 * MiB))
#define QCB ((bf16*)(ws + 24 * MiB))
#define NCB ((float*)(ws + 60 * MiB))
#define SCB ((bf16*)(ws + WS_WL))
#define LBIAS ((float*)(ws + WS_BIASP + 64 * 1024))
#define ROWSS ((float*)(ws + WS_MOD + 256 * 1024))
#define BONB ((float*)(ws + 128 * 1024))
#define AIN(k) (kp->in[k])
#define AOUT (kp->out)
#if N_LAUNCH_SPLIT
    const int lo = kp0->ph_lo, hi = kp0->ph_hi;
#else
    constexpr int lo = 0, hi = 14;
#endif
#ifndef PHMASK
#define PHMASK 0x3fff
#endif
#define IN(k) (((PHMASK >> (k)) & 1) && lo <= (k) && (k) < hi)
#ifndef DUPMASK
#define DUPMASK 0
#endif
#ifndef EXTRA_SYNCS
#define EXTRA_SYNCS 0
#endif
#define XBAR_NOW() ({ XcdBarrier xb_; KArgs kq_; asm volatile("" : "=s"(kq_) : "0"(kp0)); xb_.bar = (unsigned*)kq_->ws; xb_.x = xb_xcc_id(); xb_.st = (volatile LAS unsigned*)(lds + 131072); xb_; })
#define SEAM(k) do { if (IN(k) && IN((k) + 1)) xcd_barrier(XBAR_NOW(), get_wave(lds) == 0 && get_lane() == 0); } while (0)
#define REP(k) for (int rep_ = 0; rep_ < 1 + ((DUPMASK >> (k)) & 1); ++rep_, (void)(((DUPMASK >> (k)) & 1) && rep_ == 1 ? (xcd_barrier(XBAR_NOW(), get_wave(lds) == 0 && get_lane() == 0), 0) : 0))

    REP(0) if (IN(0)) { PHASE_PTRS();
        if (bx < 192) {
            const float* w_ada = AIN(2); const float* cvec = AIN(1); const float* b_ada = AIN(3);
            const int col0 = bx * 64, kr = tid >> 4, cq = tid & 15;
            f32x4 a0 = (f32x4){0.f, 0.f, 0.f, 0.f}, a1 = a0;
#pragma unroll 4
            for (int k = kr; k < D; k += 32) { const f32x4 w = *(const f32x4*)(w_ada + (size_t)k * MODW + col0 + cq * 4); float c0 = cvec[k], c1 = cvec[D + k]; c0 = c0 * sigm(c0); c1 = c1 * sigm(c1); a0 += c0 * w; a1 += c1 * w; }
            LAS f32x4* red = (LAS f32x4*)lds; red[(kr * 16 + cq) * 2] = a0; red[(kr * 16 + cq) * 2 + 1] = a1;
            __syncthreads();
            if (tid < 128) { const int b = tid >> 6, cc = tid & 63; const LAS float* rf = (const LAS float*)lds; float s = 0.f;
                for (int k2 = 0; k2 < 32; ++k2) s += rf[(k2 * 16 + (cc >> 2)) * 8 + b * 4 + (cc & 3)];
                MOD[b * MODW + col0 + cc] = s + b_ada[col0 + cc]; }
            __syncthreads();
        }
        LAS float* scr = (LAS float*)(lds + wave * 8448);
        const float* w_in = AIN(5);
        constexpr int I1 = 32 * 105, I2 = 32 * 40, I3 = 32 * 128, I4 = 16 * 64, I5 = 16 * 64, I6 = 32 * 64;
        for (int it = gw; it < I1 + I2 + I3; it += NGW) {
            int r = it;
            if (r < I1) { transpose_item(w_in, 8736, 0, WIN, D, 0, r / 105, r % 105, scr, lane); continue; } r -= I1;
            if (r < I2) { transpose_item(w_in, 8736, 3360, WIN, D, PC_Q, r / 40, r % 40, scr, lane); continue; } r -= I2;
            transpose_item(w_in, 8736, 4640, WIN, D, PC_GR, r / 128, r % 128, scr, lane);
        }
        (void)I4; (void)I5; (void)I6;
        const float* b_in = AIN(6);
        for (int i = gt; i < NIN; i += NT) { float v = 0.f; if (i < 3360) v = b_in[i]; else if (i >= PC_Q && i < PC_GR) v = b_in[3360 + i - PC_Q]; else if (i >= PC_GR) v = b_in[4640 + i - PC_GR]; BIASP[i] = v; }
        for (int i = gt; i < 2 * M; i += NT) ROWSS[i] = 0.f;
        for (int i = gt; i < 2 * C; i += NT) LBIAS[i] = i < C ? AIN(8)[i] : AIN(10)[i - C];
        for (int i = gt; i < 224 * D / 8; i += NT) *(u32x4*)(WIN + (size_t)3360 * D + (size_t)i * 8) = (u32x4){0u, 0u, 0u, 0u};
        const float* w2 = AIN(9); const float* a2 = AIN(11); const float* g2 = AIN(12);
        for (int i = gt; i < 3072 * 48; i += NT) { const int n = i / 48, k0 = (i % 48) * 8; float v[8];
#pragma unroll
            for (int e = 0; e < 8; ++e) { const int k = k0 + e; float t = 0.f;
                if (n < 1024) { if (k < 64) t = w2[k * C + n]; } else if (n < 2048) { if (k >= 64 && k < 128) t = a2[(k - 64) * C + n - 1024]; } else { if (k >= 128 && k < 288) t = g2[(k - 128) * C + n - 2048]; }
                v[e] = t; }
            u32x4 o; o.x = pk2(v[0], v[1]); o.y = pk2(v[2], v[3]); o.z = pk2(v[4], v[5]); o.w = pk2(v[6], v[7]);
            *(u32x4*)(WLORA + (size_t)n * KL + k0) = o; }
    }
    SEAM(0);
    for (int es_ = 0; es_ < EXTRA_SYNCS; ++es_) xcd_barrier(XBAR_NOW(), get_wave(lds) == 0 && get_lane() == 0);
    REP(1) if (IN(1)) { PHASE_PTRS(); norm_rows_bf16(AIN(0), AIN(4), MOD, D, 0, H, gw, NGW, lane); }
    SEAM(1);
    REP(2) if (IN(2)) { PHASE_PTRS(); pg8::Gemm g{H, WIN, M, NIN, D}; pg8::StaticOrder S; S.init(M, NIN, G, bx); EpiIn E{P, BIASP};
        pg8::gemm_phase<EpiIn, pg8::StaticOrder, true, true>(lds, g, S, E);
        const int nfull = (M / 256) * (NIN / 256) - ((M / 256) * (NIN / 256) / G) * G;
        if (bx >= nfull) { LAS float* scr = (LAS float*)(lds + wave * 8448);
            for (int it = (bx - nfull) * 8 + wave; it < 32 * 256 + 128 * 64; it += (G - nfull) * 8) {
                if (it < 32 * 256) transpose_item(AIN(23), FF, 0, WUP, D, 0, it / 256, it % 256, scr, lane);
                else { const int r = it - 32 * 256; transpose_item(AIN(24), D, 0, WDOWN, FF, 0, r / 64, r % 64, scr, lane); } } } }
    SEAM(2);
    REP(3) if (IN(3)) { PHASE_PTRS();
        const float* mix = AIN(7);
        for (int idx = gt; idx < M * 48; idx += NT) { const int m = idx / 48, ch = idx % 48; u32x4 o = (u32x4){0u, 0u, 0u, 0u};
            if (ch < 36) { const int col = PC_LORA + ch * 8; const u32x4 cw = *(const u32x4*)(P + (size_t)m * NIN + col); u32x4 pw = (u32x4){0u, 0u, 0u, 0u};
                if (m & (T - 1)) pw = *(const u32x4*)(P + (size_t)(m - 1) * NIN + col);
                float cv[8], pv[8];
                cv[0] = blo(cw.x); cv[1] = bhi(cw.x); cv[2] = blo(cw.y); cv[3] = bhi(cw.y); cv[4] = blo(cw.z); cv[5] = bhi(cw.z); cv[6] = blo(cw.w); cv[7] = bhi(cw.w);
                pv[0] = blo(pw.x); pv[1] = bhi(pw.x); pv[2] = blo(pw.y); pv[3] = bhi(pw.y); pv[4] = blo(pw.z); pv[5] = bhi(pw.z); pv[6] = blo(pw.w); pv[7] = bhi(pw.w);
#pragma unroll
                for (int e = 0; e < 8; ++e) { float p = cv[e] + (pv[e] - cv[e]) * mix[col + e];
                    if (ch < 8) p = 1.f - 2.f / (1.f + __expf(2.f * p)); else if (ch >= 16) p = sigm(p);
                    cv[e] = p; }
                o.x = pk2(cv[0], cv[1]); o.y = pk2(cv[2], cv[3]); o.z = pk2(cv[4], cv[5]); o.w = pk2(cv[6], cv[7]); }
            *(u32x4*)(AL + (size_t)m * KL + ch * 8) = o; }
    }
    SEAM(3);
    REP(4) if (IN(4)) { PHASE_PTRS(); pg8::Gemm g{AL, WLORA, M, 3072, KL}; pg8::StaticOrder S; S.init(M, 3072, G, bx); EpiLora E{WL, GG, LBIAS};
        pg8::gemm_phase<EpiLora, pg8::StaticOrder, true, true>(lds, g, S, E);
        const int nfull = 384 - (384 / G) * G;
        if (bx >= nfull) { LAS float* scr = (LAS float*)(lds + wave * 8448);
            for (int it = (bx - nfull) * 8 + wave; it < 16 * 64 + 16 * 64 + 32 * 64; it += (G - nfull) * 8) { int r = it;
                if (r < 16 * 64) { transpose_item(AIN(19), D, 0, WBR, C, 0, r / 64, r % 64, scr, lane); continue; } r -= 16 * 64;
                if (r < 16 * 64) { transpose_item(AIN(20), D, 0, WBA, C, 0, r / 64, r % 64, scr, lane); continue; } r -= 16 * 64;
                transpose_item(AIN(21), D, 0, WOUT, D, 0, r / 64, r % 64, scr, lane); } } }
    SEAM(4);
    REP(5) if (IN(5)) { PHASE_PTRS();
        ChunkRaw raw = chunk_load_raw(P, WL, AS, bx, tid);
        for (int q = bx; q < 2048; q += G) {
            chunk_pass_a_prep(raw, AIN(7), AIN(13), AIN(14), AIN(15), BONB, q, lds, tid);
            asm volatile("" ::: "memory");
            if (q + G < 2048) raw = chunk_load_raw(P, WL, AS, q + G, tid);
            chunk_pass_a_mm(MCB, QCB, NCB, (float*)AOUT, q, lds, tid);
        }
    }
    SEAM(5);
    REP(6) if (IN(6)) { PHASE_PTRS();
        if (bx < 128) { volatile LAS int* prog = (volatile LAS int*)(lds + 131072 + 256);
            if (tid == 0) *prog = 0;
            __syncthreads();
            if (wave == 0) chunk_pass_b(MCB, NCB, SCB, bx >> 2, bx & 3, lane, prog);
            }
        else for (int u = bx - 128; u < 256; u += G - 128) attn_unit(P, AIN(18), YATT, u, lds, tid);
    }
    SEAM(6);
    REP(7) if (IN(7)) { PHASE_PTRS();
        { int it = 0; for (int q = bx; q < 2048; q += G, ++it) chunk_pass_c_fin(QCB, SCB, (const float*)AOUT, P, BONB, GG, AIN(7), AIN(16), AIN(17), YR, q, it, lds, tid, wave, lane); }
    }
    SEAM(7);
    REP(9) if (IN(9)) { PHASE_PTRS();
        { pg8::Gemm g{YR, WBR, M, D, C}; pg8::StaticOrder S; S.init(M, D, G, bx); EpiBr<0> E{P, TMPB, MG};
          pg8::gemm_phase<EpiBr<0>, pg8::StaticOrder, true, true>(lds, g, S, E); }
        { pg8::Gemm g{YATT, WBA, M, D, C}; pg8::StaticOrder S; S.init(M, D, G, bx); EpiBr<1> E{P, TMPB, MG};
          pg8::gemm_phase<EpiBr<1>, pg8::StaticOrder, true, true>(lds, g, S, E); }
    }
    SEAM(9);
    REP(10) if (IN(10)) { PHASE_PTRS();
        pg8::Gemm g{MG, WOUT, M, D, D}; pg8::StaticOrder S; S.init(M, D, G, bx); EpiResNorm<0> E{AIN(0), X1, MOD + 2 * D, ROWSS, AIN(22), MOD, H, nullptr, (unsigned*)ws};
        pg8::gemm_phase<EpiResNorm<0>, pg8::StaticOrder, false, true>(lds, g, S, E); }
    SEAM(10);
    REP(12) if (IN(12)) { PHASE_PTRS(); pg8::Gemm g{H, WUP, M, FF, D}; pg8::StaticOrder S; S.init(M, FF, G, bx); EpiUp E{U};
        pg8::gemm_phase<EpiUp, pg8::StaticOrder, true, true>(lds, g, S, E); }
    SEAM(12);
    REP(13) if (IN(13)) { PHASE_PTRS(); pg8::Gemm g{U, WDOWN, M, D, FF}; pg8::StaticOrder S; S.init(M, D, G, bx); EpiResNorm<1> E{X1, nullptr, MOD + 5 * D, ROWSS + M, AIN(25), MOD, nullptr, AOUT, (unsigned*)ws};
        pg8::gemm_phase<EpiResNorm<1>, pg8::StaticOrder, false, true>(lds, g, S, E); }
#undef IN
#undef SEAM
}

extern "C" void kernel_launch(void* const* d_in, const int* in_sizes, int n_in, void* d_out, int out_size, void* d_ws, size_t ws_size, hipStream_t stream) {
    static int grid = 0;
    if (grid == 0) {
        int dev = 0, cus = 0, per_cu = 0;
        hipGetDevice(&dev);
        hipDeviceGetAttribute(&cus, hipDeviceAttributeMultiprocessorCount, dev);
        hipFuncSetAttribute((const void*)fwd, hipFuncAttributeMaxDynamicSharedMemorySize, LDS_BYTES);
        hipOccupancyMaxActiveBlocksPerMultiprocessor(&per_cu, (const void*)fwd, 512, LDS_BYTES);
        if (per_cu < 1) { fprintf(stderr, "kernel_launch: occupancy query says %d blocks per CU\n", per_cu); per_cu = 1; }
        if (per_cu > 1) per_cu = 1;
        grid = cus * per_cu;
        if (grid > 256) grid = 256;
        (void)hipGetLastError();
    }
    (void)hipMemsetAsync(d_ws, 0, 16384, stream);
    Args a{};
    for (int i = 0; i < 26; ++i) a.in[i] = (const float*)d_in[i];
    a.out = (float*)d_out; a.ws = (unsigned char*)d_ws;
#if N_LAUNCH_SPLIT
    for (int p = 0; p < 14; ++p) { a.ph_lo = p; a.ph_hi = p + 1; hipLaunchKernelGGL(fwd, dim3(grid), dim3(512), LDS_BYTES, stream, a); }
#else
    a.ph_lo = 0; a.ph_hi = 14;
    void* args[] = {&a};
    hipError_t e = hipLaunchCooperativeKernel((const void*)fwd, dim3(grid), dim3(512), args, LDS_BYTES, stream);
    if (e != hipSuccess) fprintf(stderr, "cooperative launch failed: %s (grid %d)\n", hipGetErrorString(e), grid);
#endif
}
```
